# Optimizing an MI355X kernel written in HIP

```python
import jax, jax.numpy as jnp
from jax import lax
import numpy as np

D_MODEL = 1024
BATCH = 8
SEQ = 2048
DEPTH = 1
DEC_BATCH = 32
DEC_SEQ = 4
PAST_LEN = 16384
PAGE_SIZE = 128

N_HEADS = 8
HEAD_DIM = 64
N_KV = 2
HPG = N_HEADS // N_KV
NSA_W = N_HEADS * HEAD_DIM
KV_W = N_KV * HEAD_DIM
CMP_LEN = 32
CMP_STRIDE = 16
CMP_R = CMP_LEN // CMP_STRIDE
CMP_HID = HEAD_DIM
SLC_LEN = 64
TOP_N = 16
WINDOW = 512
CONV_C = D_MODEL // 2
CONV_W = 31
Q_BLOCK = 64
SPLITS = (NSA_W, 6 * KV_W, 3 * N_HEADS, NSA_W, 2 * CONV_C, CONV_C, 2 * D_MODEL)
D_IN = NSA_W + 6 * KV_W + 3 * N_HEADS + NSA_W + 2 * CONV_C + CONV_C + 2 * D_MODEL
EPS = 1e-6
FORCED_SCORE = 1e4
NEG_INF = -1e30

kernel_name = 'nsa_conformer_gated_hybrid_step'


def split_cols(z, widths):
    outs, start = [], 0
    for w in widths:
        outs.append(z[..., start:start + w])
        start += w
    return outs


def rmsnorm(x, g):
    xf = x.astype(jnp.float32)
    y = xf * lax.rsqrt(jnp.mean(xf * xf, axis=-1, keepdims=True) + EPS)
    return (y * g.astype(jnp.float32)).astype(x.dtype)


def layernorm(x, g, b):
    xf = x.astype(jnp.float32)
    mu = jnp.mean(xf, axis=-1, keepdims=True)
    var = jnp.mean(jnp.square(xf - mu), axis=-1, keepdims=True)
    y = (xf - mu) * lax.rsqrt(var + EPS) * g.astype(jnp.float32) + b.astype(jnp.float32)
    return y.astype(x.dtype)


def masked_softmax(s, mask):
    s = jnp.where(mask, s.astype(jnp.float32), NEG_INF)
    e = jnp.where(mask, jnp.exp(s - jnp.max(s, axis=-1, keepdims=True)), 0.0)
    return e / jnp.maximum(jnp.sum(e, axis=-1, keepdims=True), 1e-30)


def compress(k, pe, w1, w2):
    B, T = k.shape[:2]
    n_chunk = T // CMP_STRIDE
    n_cmp = n_chunk - CMP_R + 1
    kc = k[:, :n_chunk * CMP_STRIDE].reshape(B, n_chunk, CMP_STRIDE, N_KV, HEAD_DIM)
    w1r = w1.reshape(CMP_R, CMP_STRIDE, HEAD_DIM, CMP_HID)
    per = jnp.einsum('bcjgd,rjdh->rbcgh', kc, w1r)
    h = jnp.einsum('rjd,rjdh->h', pe.reshape(CMP_R, CMP_STRIDE, HEAD_DIM), w1r)
    for r in range(CMP_R):
        h = h + per[r, :, r:r + n_cmp]
    return jax.nn.silu(h) @ w2


def to_blocks(k):
    B, T = k.shape[:2]
    n_slc = -(-T // SLC_LEN)
    k = jnp.pad(k, ((0, 0), (0, n_slc * SLC_LEN - T), (0, 0), (0, 0)))
    return k.reshape(B, n_slc, SLC_LEN, N_KV, HEAD_DIM).transpose(0, 3, 1, 2, 4)


def cmp_to_slc(n_cmp, n_slc):
    i = jnp.arange(n_cmp)[:, None] * CMP_STRIDE
    j = jnp.arange(n_slc)[None, :] * SLC_LEN
    return ((i < j + SLC_LEN) & (i + CMP_LEN > j)).astype(jnp.float32)


def nsa_context(k_c, v_c, k_s, v_s, pe_k, w1_k, w2_k, pe_v, w1_v, w2_v):
    kc = compress(k_c, pe_k, w1_k, w2_k)
    vc = compress(v_c, pe_v, w1_v, w2_v)
    n_cmp = kc.shape[1]
    c_end = jnp.arange(n_cmp) * CMP_STRIDE + (CMP_LEN - 1)
    ks_bg, vs_bg = to_blocks(k_s), to_blocks(v_s)
    agg = cmp_to_slc(n_cmp, ks_bg.shape[2])
    return kc, vc, c_end, agg, ks_bg, vs_bg


def nsa_block(q, gates, q_pos, ctx, kw, vw, w_pos):
    kc, vc, c_end, agg, ks_bg, vs_bg = ctx
    B, Q = q.shape[:2]
    qf = q * (HEAD_DIM ** -0.5)
    s_c = jnp.einsum('bqghd,bcgd->bqghc', qf, kc)
    m_c = (c_end[None, :] <= q_pos[:, None])[None, :, None, None, :]
    p_c = masked_softmax(s_c, m_c)
    o_c = jnp.einsum('bqghc,bcgd->bqghd', p_c.astype(vc.dtype), vc)
    n_slc = ks_bg.shape[2]
    imp = jnp.einsum('bqgc,cj->bqgj', jnp.sum(p_c, axis=3), agg)
    j = jnp.arange(n_slc)[None, :]
    cur = (q_pos // SLC_LEN)[:, None]
    valid = j * SLC_LEN <= q_pos[:, None]
    forced = (j == 0) | (j == cur) | (j == cur - 1)
    score = jnp.where(forced[None, :, None, :], FORCED_SCORE, imp)
    score = jnp.where(valid[None, :, None, :], score, -1.0)
    n_top = min(TOP_N, n_slc)
    _, idx = lax.top_k(score, n_top)
    idx = idx.transpose(0, 2, 1, 3)
    b_i = jnp.arange(B)[:, None, None, None]
    g_i = jnp.arange(N_KV)[None, :, None, None]
    n_sel = n_top * SLC_LEN
    k_sel = ks_bg[b_i, g_i, idx].reshape(B, N_KV, Q, n_sel, HEAD_DIM)
    v_sel = vs_bg[b_i, g_i, idx].reshape(B, N_KV, Q, n_sel, HEAD_DIM)
    key_pos = (idx[..., None] * SLC_LEN + jnp.arange(SLC_LEN)).reshape(B, N_KV, Q, n_sel)
    m_s = (key_pos <= q_pos[None, None, :, None]).transpose(0, 2, 1, 3)[:, :, :, None, :]
    s_s = jnp.einsum('bqghd,bgqnd->bqghn', qf, k_sel)
    p_s = masked_softmax(s_s, m_s)
    o_s = jnp.einsum('bqghn,bgqnd->bqghd', p_s.astype(v_sel.dtype), v_sel)
    wp, qp = w_pos[None, :], q_pos[:, None]
    m_w = ((wp <= qp) & (wp >= qp - WINDOW) & (wp >= 0))[None, :, None, None, :]
    s_w = jnp.einsum('bqghd,bwgd->bqghw', qf, kw)
    p_w = masked_softmax(s_w, m_w)
    o_w = jnp.einsum('bqghw,bwgd->bqghd', p_w.astype(vw.dtype), vw)
    g = jax.nn.sigmoid(gates.astype(jnp.float32)).astype(q.dtype)
    return g[..., 0:1] * o_c + g[..., 1:2] * o_s + g[..., 2:3] * o_w


def attend_prompt(q, gates, k_c, v_c, k_s, v_s, k_w, v_w, cmp_params):
    B, T = q.shape[:2]
    ctx = nsa_context(k_c, v_c, k_s, v_s, *cmp_params)
    pad = ((0, 0), (WINDOW, 0), (0, 0), (0, 0))
    kw_pad, vw_pad = jnp.pad(k_w, pad), jnp.pad(v_w, pad)
    n_qb = T // Q_BLOCK

    def blocks(t):
        return t.reshape((B, n_qb, Q_BLOCK) + t.shape[2:]).swapaxes(0, 1)

    def step(args):
        qb, gb, s = args
        q_pos = s + jnp.arange(Q_BLOCK)
        kw = lax.dynamic_slice_in_dim(kw_pad, s, WINDOW + Q_BLOCK, axis=1)
        vw = lax.dynamic_slice_in_dim(vw_pad, s, WINDOW + Q_BLOCK, axis=1)
        w_pos = s - WINDOW + jnp.arange(WINDOW + Q_BLOCK)
        return nsa_block(qb, gb, q_pos, ctx, kw, vw, w_pos)

    out = lax.map(step, (blocks(q), blocks(gates), jnp.arange(n_qb) * Q_BLOCK))
    return out.swapaxes(0, 1).reshape(B, T, NSA_W)


def gather_pages(pool, page_table):
    g = pool[page_table]
    return g.reshape(page_table.shape[0], -1, N_KV, HEAD_DIM)


def make_attend_sample(pool_k_c, pool_v_c, pool_k_s, pool_v_s, buf_k, buf_v, page_table):
    def attend(q, gates, k_c, v_c, k_s, v_s, k_w, v_w, cmp_params):
        def full(pool, new):
            return jnp.concatenate([gather_pages(pool, page_table), new], axis=1)
        ctx = nsa_context(full(pool_k_c, k_c), full(pool_v_c, v_c),
                          full(pool_k_s, k_s), full(pool_v_s, v_s), *cmp_params)
        n_new = q.shape[1]
        n_buf = buf_k.shape[1]
        q_pos = PAST_LEN + jnp.arange(n_new)
        kw = jnp.concatenate([buf_k, k_w], axis=1)
        vw = jnp.concatenate([buf_v, v_w], axis=1)
        w_pos = PAST_LEN - n_buf + jnp.arange(n_buf + n_new)
        out = nsa_block(q, gates, q_pos, ctx, kw, vw, w_pos)
        return out.reshape(q.shape[0], n_new, NSA_W)
    return attend


def mixer_layer(x, conv_buf, attend, ln_g, w_in, pe_k, w1_k, w2_k, pe_v, w1_v, w2_v,
                dw_k, dw_b, cln_g, cln_b, pw_w, pw_b, w_pa, w_pb, w_o):
    B, T, _ = x.shape
    xn = rmsnorm(x, ln_g)
    q, kv, g_nsa, g_a, glu, g_b, g_mrg = split_cols(xn @ w_in, SPLITS)
    k_c, v_c, k_s, v_s, k_w, v_w = [t.reshape(B, T, N_KV, HEAD_DIM) for t in split_cols(kv, (KV_W,) * 6)]
    q = q.reshape(B, T, N_KV, HPG, HEAD_DIM)
    g_nsa = g_nsa.reshape(B, T, N_KV, HPG, 3)
    o_a = attend(q, g_nsa, k_c, v_c, k_s, v_s, k_w, v_w, (pe_k, w1_k, w2_k, pe_v, w1_v, w2_v))
    u_val, u_gate = split_cols(glu, (CONV_C, CONV_C))
    u = u_val * jax.nn.sigmoid(u_gate)
    up = jnp.concatenate([conv_buf, u], axis=1)
    c = lax.conv_general_dilated(up, dw_k[:, None, :], (1,), 'VALID',
                                 dimension_numbers=('NWC', 'WIO', 'NWC'),
                                 feature_group_count=CONV_C) + dw_b
    c = jax.nn.silu(layernorm(c, cln_g, cln_b)) @ pw_w + pw_b
    br_a = (o_a * jax.nn.silu(g_a)) @ w_pa
    br_b = (c * jax.nn.silu(g_b)) @ w_pb
    m_a, m_b = split_cols(g_mrg, (D_MODEL, D_MODEL))
    h = jax.nn.sigmoid(m_a) * br_a + jax.nn.sigmoid(m_b) * br_b
    return x + h @ w_o, (k_c, v_c, k_s, v_s, k_w, v_w, up[:, -(CONV_W - 1):])


def setup_inputs(seed: int = 0) -> dict:
    key = jax.random.key(seed)
    ks = jax.random.split(key, 40)
    n_pages = PAST_LEN // PAGE_SIZE
    n_pool = (DEC_BATCH * n_pages * 5) // 4
    win_buf = min(WINDOW, PAST_LEN)

    def nrm(k, shape, scale):
        return jax.random.normal(k, shape, jnp.float32) * scale

    pool_shape = (DEPTH, n_pool, PAGE_SIZE, N_KV, HEAD_DIM)
    win_shape = (DEPTH, DEC_BATCH, win_buf, N_KV, HEAD_DIM)
    page_table = jax.random.permutation(ks[10], n_pool)[: DEC_BATCH * n_pages]
    page_table = page_table.reshape(DEC_BATCH, n_pages).astype(jnp.int32)
    return {
        'x_prompt': nrm(ks[0], (BATCH, SEQ, D_MODEL), 1.0),
        'x_sample': nrm(ks[1], (DEC_BATCH, DEC_SEQ, D_MODEL), 1.0),
        'cache_k_cmp': nrm(ks[2], pool_shape, 1.0),
        'cache_v_cmp': nrm(ks[3], pool_shape, 1.0),
        'cache_k_slc': nrm(ks[4], pool_shape, 1.0),
        'cache_v_slc': nrm(ks[5], pool_shape, 1.0),
        'cache_k_win': nrm(ks[6], win_shape, 1.0),
        'cache_v_win': nrm(ks[7], win_shape, 1.0),
        'state_conv': nrm(ks[8], (DEPTH, DEC_BATCH, CONV_W - 1, CONV_C), 0.5),
        'page_table': page_table,
        'ln_g': 1.0 + nrm(ks[11], (DEPTH, D_MODEL), 0.02),
        'w_in': nrm(ks[12], (DEPTH, D_MODEL, D_IN), D_MODEL ** -0.5),
        'pe_k': nrm(ks[13], (DEPTH, CMP_LEN, HEAD_DIM), 0.1),
        'w1_k': nrm(ks[14], (DEPTH, CMP_LEN * HEAD_DIM, CMP_HID), (CMP_LEN * HEAD_DIM) ** -0.5),
        'w2_k': nrm(ks[15], (DEPTH, CMP_HID, HEAD_DIM), CMP_HID ** -0.5),
        'pe_v': nrm(ks[16], (DEPTH, CMP_LEN, HEAD_DIM), 0.1),
        'w1_v': nrm(ks[17], (DEPTH, CMP_LEN * HEAD_DIM, CMP_HID), (CMP_LEN * HEAD_DIM) ** -0.5),
        'w2_v': nrm(ks[18], (DEPTH, CMP_HID, HEAD_DIM), CMP_HID ** -0.5),
        'dw_k': nrm(ks[19], (DEPTH, CONV_W, CONV_C), CONV_W ** -0.5),
        'dw_b': nrm(ks[20], (DEPTH, CONV_C), 0.02),
        'cln_g': 1.0 + nrm(ks[21], (DEPTH, CONV_C), 0.02),
        'cln_b': nrm(ks[22], (DEPTH, CONV_C), 0.02),
        'pw_w': nrm(ks[23], (DEPTH, CONV_C, CONV_C), CONV_C ** -0.5),
        'pw_b': nrm(ks[24], (DEPTH, CONV_C), 0.02),
        'w_pa': nrm(ks[25], (DEPTH, NSA_W, D_MODEL), NSA_W ** -0.5),
        'w_pb': nrm(ks[26], (DEPTH, CONV_C, D_MODEL), CONV_C ** -0.5),
        'w_o': nrm(ks[27], (DEPTH, D_MODEL, D_MODEL), D_MODEL ** -0.5),
        'final_g': 1.0 + nrm(ks[28], (D_MODEL,), 0.02),
    }


def reference(x_prompt, x_sample, cache_k_cmp, cache_v_cmp, cache_k_slc, cache_v_slc,
              cache_k_win, cache_v_win, state_conv, page_table,
              ln_g, w_in, pe_k, w1_k, w2_k, pe_v, w1_v, w2_v,
              dw_k, dw_b, cln_g, cln_b, pw_w, pw_b, w_pa, w_pb, w_o, final_g):
    xp, xs = x_prompt, x_sample
    win_p = min(WINDOW, xp.shape[1])
    win_s = cache_k_win.shape[2]
    pst = [[] for _ in range(7)]
    sst = [[] for _ in range(7)]
    for l in range(DEPTH):
        params = (ln_g[l], w_in[l], pe_k[l], w1_k[l], w2_k[l], pe_v[l], w1_v[l], w2_v[l],
                  dw_k[l], dw_b[l], cln_g[l], cln_b[l], pw_w[l], pw_b[l], w_pa[l], w_pb[l], w_o[l])
        zero_buf = jnp.zeros((xp.shape[0], CONV_W - 1, CONV_C), xp.dtype)
        xp, sp = mixer_layer(xp, zero_buf, attend_prompt, *params)
        attend_s = make_attend_sample(cache_k_cmp[l], cache_v_cmp[l], cache_k_slc[l], cache_v_slc[l],
                                      cache_k_win[l], cache_v_win[l], page_table)
        xs, ss = mixer_layer(xs, state_conv[l], attend_s, *params)
        p_rows = (sp[0], sp[1], sp[2], sp[3], sp[4][:, -win_p:], sp[5][:, -win_p:], sp[6])
        s_rows = (ss[0], ss[1], ss[2], ss[3],
                  jnp.concatenate([cache_k_win[l], ss[4]], axis=1)[:, -win_s:],
                  jnp.concatenate([cache_v_win[l], ss[5]], axis=1)[:, -win_s:], ss[6])
        for i in range(7):
            pst[i].append(p_rows[i])
            sst[i].append(s_rows[i])
    y_prompt = rmsnorm(xp, final_g)
    y_sample = rmsnorm(xs, final_g)
    p_k_cmp, p_v_cmp, p_k_slc, p_v_slc, p_k_win, p_v_win, p_conv = [jnp.stack(t, 0) for t in pst]
    s_k_cmp, s_v_cmp, s_k_slc, s_v_slc, s_k_win, s_v_win, s_conv = [jnp.stack(t, 0) for t in sst]
    return (y_prompt, y_sample, p_k_cmp, p_v_cmp, p_k_slc, p_v_slc, p_k_win, p_v_win, p_conv,
            s_k_cmp, s_v_cmp, s_k_slc, s_v_slc, s_k_win, s_v_win, s_conv)
```

```cpp
#define MK_N_LAUNCHES 1
#include <hip/hip_runtime.h>
#include <cstdio>
#include <cstdint>
#include <cmath>
namespace pg8 {
#define PG8_LAS __attribute__((address_space(3)))
typedef unsigned short bf16_t;
typedef short bf16x8 __attribute__((ext_vector_type(8)));
typedef float f32x4 __attribute__((ext_vector_type(4)));
typedef unsigned u32x4 __attribute__((ext_vector_type(4)));
constexpr int BM = 256, BK = 64, HALF = 128, HTB = HALF * BK * 2  , STAGE_BYTES = 8 * HTB, NXCD = 8, WGM = 8;

__host__ __device__ __forceinline__ int lds_byte(int r, int c) { const int st = (r >> 4) * 2 + (c >> 5), rr = r & 15, cc = c & 31, ob = rr * 64 + cc * 2; return st * 1024 + (ob ^ (((ob >> 9) & 1) << 5)); }
__host__ __device__ __forceinline__ void stage_rc(int b, int& R, int& C) { const int st = b / 1024, sb = b % 1024, swz = sb ^ (((sb >> 9) & 1) << 5); R = (st >> 1) * 16 + swz / 64; C = (st & 1) * 32 + (swz % 64) / 2; }
__host__ __device__ __forceinline__ int perm32(int rho) { const int n = rho >> 4, i = rho & 15; return 8 * (i >> 2) + 4 * n + (i & 3); }

struct Unit { int pm, pn; };
struct Gemm { const bf16_t* A; const bf16_t* Bt; int M, N, K; };

struct StaticOrder {
    int nM, nN, nwg, G, c;
    __host__ __device__ void init(int M, int N, int G_, int c_) { nM = M / BM; nN = N / BM; nwg = nM * nN; G = G_; c = c_; }
    __host__ __device__ bool next(int i, Unit& u) const {
        const long L = (long)i * G + c; if (L >= nwg) return false;
        int wgid = (int)L; { const int q = nwg / NXCD, r = nwg % NXCD, xcd = wgid % NXCD, off = wgid / NXCD; wgid = (xcd < r ? xcd * (q + 1) : r * (q + 1) + (xcd - r) * q) + off; }
        const int nig = WGM * nN, gid = wgid / nig, fm = gid * WGM, gsz = (nM - fm) < WGM ? (nM - fm) : WGM;
        u.pm = fm + ((wgid % nig) % gsz); u.pn = (wgid % nig) / gsz; return true;
    }
    __device__ __forceinline__ void a_ready(const Unit&) const {}
    __device__ __forceinline__ void done(const Unit&) const {}
};

__device__ __forceinline__ unsigned cvt_pk_bf16(float lo, float hi) { unsigned r; asm volatile("v_cvt_pk_bf16_f32 %0, %1, %2" : "=v"(r) : "v"(lo), "v"(hi)); return r; }
typedef float f32x2 __attribute__((ext_vector_type(2)));
template <class Epi, class Sched, bool ALIGN_EPI = false, bool SP2 = false>
__device__ __forceinline__ void gemm_phase(PG8_LAS unsigned char* lds, const Gemm g, const Sched& S, const Epi& E) {
    const int tid = threadIdx.x, wid = __builtin_amdgcn_readfirstlane(tid >> 6), lane = tid & 63, wr = wid >> 2, wc = wid & 3, fr = lane & 15, fq = lane >> 4;
    const int K = g.K, nt = K / BK;
    unsigned voffA[2], voffB[2];
#pragma unroll
    for (int i = 0; i < 2; ++i) { int R, C; stage_rc(tid * 16 + i * 8192, R, C); const int Rb = Epi::PERM ? ((R & ~31) + perm32(R & 31)) : R;
        voffA[i] = (unsigned)(R * K + C) * 2u; voffB[i] = (unsigned)(Rb * K + C) * 2u; }
    const size_t kstep = (size_t)(BK * 2);
    const size_t hstep = (size_t)HALF * K * 2;
    const size_t tstep = 2 * hstep;
    const unsigned ldsw = (unsigned)wid * 1024u;
    const int aoff = lds_byte(wr * 64 + fr, fq * 8), boff = lds_byte(wc * 32 + fr, fq * 8);
#define PG8_SA(b, h) (((b) * 2 + (h)) * HTB)
#define PG8_SB(b, h) ((4 + (b) * 2 + (h)) * HTB)
#define PG8_STAGE(bufoff, gbase, voff) do { _Pragma("unroll") for (int _i = 0; _i < 2; ++_i) \
        __builtin_amdgcn_global_load_lds((const unsigned*)((const char*)(gbase) + (voff)[_i]), (PG8_LAS unsigned*)(lds + (bufoff) + ldsw + _i * 8192), 16, 0, 0); } while (0)
#define PG8_LDA(dst, b, h) do { _Pragma("unroll") for (int m = 0; m < 4; ++m) _Pragma("unroll") for (int k = 0; k < 2; ++k) dst[m][k] = *(const PG8_LAS bf16x8*)(lds + PG8_SA(b, h) + aoff + m * 2048 + k * 1024); } while (0)
#define PG8_LDB(dst, b, h) do { _Pragma("unroll") for (int n = 0; n < 2; ++n) _Pragma("unroll") for (int k = 0; k < 2; ++k) dst[n][k] = *(const PG8_LAS bf16x8*)(lds + PG8_SB(b, h) + boff + n * 2048 + k * 1024); } while (0)
#define PG8_MMA(ai, bj, At, Bt) do { __builtin_amdgcn_s_setprio(1); _Pragma("unroll") for (int m = 0; m < 4; ++m) _Pragma("unroll") for (int n = 0; n < 2; ++n) _Pragma("unroll") for (int k = 0; k < 2; ++k) \
        acc[ai][bj][m][n] = __builtin_amdgcn_mfma_f32_16x16x32_bf16(Bt[n][k], At[m][k], acc[ai][bj][m][n], 0, 0, 0); __builtin_amdgcn_s_setprio(0); } while (0)
#define PG8_WAIT_V(n) asm volatile("s_waitcnt vmcnt(" #n ")" ::: "memory")
#define PG8_WAIT_L(n) asm volatile("s_waitcnt lgkmcnt(" #n ")" ::: "memory")
#define PG8_BAR __builtin_amdgcn_s_barrier()
#define PG8_SCHED __builtin_amdgcn_sched_barrier(0)
    Unit cur, nxt; int ui = 0;
    if (!S.next(0, cur)) return;
    f32x4 acc[2][2][4][2];
#pragma unroll
    for (int a = 0; a < 2; ++a)
#pragma unroll
        for (int b = 0; b < 2; ++b)
#pragma unroll
            for (int m = 0; m < 4; ++m)
#pragma unroll
                for (int n = 0; n < 2; ++n) acc[a][b][m][n] = (f32x4){0.f, 0.f, 0.f, 0.f};
    bf16x8 At[4][2], B0[2][2], B1[2][2];
    const char* cA = (const char*)g.A + (size_t)cur.pm * tstep; const char* cB = (const char*)g.Bt + (size_t)cur.pn * tstep;
    S.a_ready(cur);
    if constexpr (SP2) {
        PG8_STAGE(PG8_SB(0, 0), cB, voffB); PG8_STAGE(PG8_SB(0, 1), cB + hstep, voffB); PG8_STAGE(PG8_SA(0, 0), cA, voffA); PG8_STAGE(PG8_SA(0, 1), cA + hstep, voffA);
        if (wr == 1) PG8_BAR;
        PG8_WAIT_V(2); PG8_BAR;
        PG8_STAGE(PG8_SB(1, 0), cB + kstep, voffB); PG8_STAGE(PG8_SA(1, 0), cA + kstep, voffA); PG8_STAGE(PG8_SB(1, 1), cB + hstep + kstep, voffB);
        PG8_WAIT_V(6); PG8_BAR;
    } else {
        PG8_STAGE(PG8_SB(0, 0), cB, voffB); PG8_STAGE(PG8_SA(0, 0), cA, voffA); PG8_STAGE(PG8_SB(0, 1), cB + hstep, voffB); PG8_STAGE(PG8_SA(0, 1), cA + hstep, voffA);
        if (wr == 1) PG8_BAR;
        PG8_WAIT_V(4); PG8_BAR;
        PG8_STAGE(PG8_SB(1, 0), cB + kstep, voffB); PG8_STAGE(PG8_SA(1, 0), cA + kstep, voffA); PG8_STAGE(PG8_SB(1, 1), cB + hstep + kstep, voffB);
        PG8_WAIT_V(6); PG8_BAR;
    }
    for (;;) {
        const bool has_next = S.next(ui + 1, nxt);
        const char* nA = has_next ? (const char*)g.A + (size_t)nxt.pm * tstep : cA; const char* nB = has_next ? (const char*)g.Bt + (size_t)nxt.pn * tstep : cB;
        for (int t = 0; t < nt; t += 2) {
            const bool last = (t == nt - 2);
            const char* a1 = cA + (size_t)(t + 1) * kstep;
            const char* a2 = last ? nA : cA + (size_t)(t + 2) * kstep; const char* b2 = last ? nB : cB + (size_t)(t + 2) * kstep;
            const char* a3 = a2 + kstep; const char* b3 = b2 + kstep;
            if (last && has_next) S.a_ready(nxt);
            if constexpr (SP2) {
            PG8_LDB(B0, 0, 0); PG8_LDB(B1, 0, 1); PG8_SCHED; PG8_LDA(At, 0, 0); PG8_STAGE(PG8_SA(1, 1), a1 + hstep, voffA);
            PG8_WAIT_V(8); PG8_WAIT_L(0); PG8_BAR; PG8_MMA(0, 0, At, B0); PG8_MMA(0, 1, At, B1); PG8_BAR; PG8_SCHED;
            PG8_LDA(At, 0, 1); PG8_STAGE(PG8_SB(0, 0), b2, voffB); PG8_STAGE(PG8_SB(0, 1), b2 + hstep, voffB); PG8_STAGE(PG8_SA(0, 0), a2, voffA);
            PG8_WAIT_V(8); PG8_WAIT_L(0); PG8_BAR; PG8_MMA(1, 0, At, B0); PG8_MMA(1, 1, At, B1); PG8_BAR; PG8_SCHED;
            PG8_LDB(B0, 1, 0); PG8_LDB(B1, 1, 1); PG8_SCHED; PG8_LDA(At, 1, 0); PG8_STAGE(PG8_SA(0, 1), a2 + hstep, voffA);
            PG8_WAIT_V(8); PG8_WAIT_L(0); PG8_BAR; PG8_MMA(0, 0, At, B0); PG8_MMA(0, 1, At, B1); PG8_BAR; PG8_SCHED;
            PG8_LDA(At, 1, 1); PG8_STAGE(PG8_SB(1, 0), b3, voffB); PG8_STAGE(PG8_SB(1, 1), b3 + hstep, voffB); PG8_STAGE(PG8_SA(1, 0), a3, voffA);
            PG8_WAIT_V(8); PG8_WAIT_L(0); PG8_BAR; PG8_MMA(1, 0, At, B0); PG8_MMA(1, 1, At, B1); PG8_BAR; PG8_SCHED;
            } else {
            PG8_LDB(B0, 0, 0); PG8_SCHED; PG8_LDA(At, 0, 0); PG8_STAGE(PG8_SA(1, 1), a1 + hstep, voffA);
            PG8_WAIT_L(8); PG8_BAR; PG8_WAIT_L(0); PG8_MMA(0, 0, At, B0); PG8_BAR; PG8_SCHED;
            PG8_LDB(B1, 0, 1); PG8_STAGE(PG8_SB(0, 0), b2, voffB);
            PG8_BAR; PG8_WAIT_L(0); PG8_MMA(0, 1, At, B1); PG8_BAR;
            PG8_LDA(At, 0, 1); PG8_STAGE(PG8_SA(0, 0), a2, voffA);
            PG8_BAR; PG8_WAIT_L(0); PG8_MMA(1, 0, At, B0); PG8_BAR; PG8_SCHED;
            PG8_STAGE(PG8_SB(0, 1), b2 + hstep, voffB);
            PG8_WAIT_V(6); PG8_BAR; PG8_MMA(1, 1, At, B1); PG8_BAR;
            PG8_LDB(B0, 1, 0); PG8_SCHED; PG8_LDA(At, 1, 0); PG8_STAGE(PG8_SA(0, 1), a2 + hstep, voffA);
            PG8_WAIT_L(8); PG8_BAR; PG8_WAIT_L(0); PG8_MMA(0, 0, At, B0); PG8_BAR; PG8_SCHED;
            PG8_LDB(B1, 1, 1); PG8_STAGE(PG8_SB(1, 0), b3, voffB);
            PG8_BAR; PG8_WAIT_L(0); PG8_MMA(0, 1, At, B1); PG8_BAR;
            PG8_LDA(At, 1, 1); PG8_STAGE(PG8_SA(1, 0), a3, voffA);
            PG8_BAR; PG8_WAIT_L(0); PG8_MMA(1, 0, At, B0); PG8_BAR; PG8_SCHED;
            PG8_STAGE(PG8_SB(1, 1), b3 + hstep, voffB);
            PG8_WAIT_V(6); PG8_BAR; PG8_MMA(1, 1, At, B1); PG8_BAR;
            }
        }
        if constexpr (ALIGN_EPI) { if (wr == 0) PG8_BAR; }
        if constexpr (!Epi::AFTER_DRAIN) { E(acc, cur, wr, wc, fr, fq); S.done(cur); }
        if (!has_next) break;
#pragma unroll
        for (int a = 0; a < 2; ++a)
#pragma unroll
            for (int b = 0; b < 2; ++b)
#pragma unroll
                for (int m = 0; m < 4; ++m)
#pragma unroll
                    for (int n = 0; n < 2; ++n) acc[a][b][m][n] = (f32x4){0.f, 0.f, 0.f, 0.f};
        cur = nxt; cA = nA; cB = nB; ++ui;
        if constexpr (ALIGN_EPI) { if (wr == 1) PG8_BAR; }
    }
    PG8_WAIT_V(0);
    if constexpr (!ALIGN_EPI) { if (wr == 0) PG8_BAR; }
    PG8_BAR;
    if constexpr (Epi::AFTER_DRAIN) { E.fused(acc, cur, wr, wc, fr, fq, lds, wid, lane); S.done(cur); }
#undef PG8_SA
#undef PG8_SB
#undef PG8_STAGE
#undef PG8_LDA
#undef PG8_LDB
#undef PG8_MMA
#undef PG8_WAIT_V
#undef PG8_WAIT_L
#undef PG8_BAR
#undef PG8_SCHED
}
}

#define GAS __attribute__((address_space(1)))
#define LAS __attribute__((address_space(3)))
typedef unsigned short bf16;
typedef short bf16x8 __attribute__((ext_vector_type(8)));
typedef short s16x4 __attribute__((ext_vector_type(4)));
typedef float f32x4 __attribute__((ext_vector_type(4)));
typedef float f32x16 __attribute__((ext_vector_type(16)));
typedef unsigned u32x4 __attribute__((ext_vector_type(4)));
typedef unsigned u32x2 __attribute__((ext_vector_type(2)));
typedef GAS unsigned gu32;

constexpr int NWAVES = 8, NTHR = 512;
constexpr int D = 1024, NB = 8, SEQ = 2048, DB = 32, DS = 4, PAST = 16384;
constexpr int MP = NB * SEQ, MS = DB * DS, MR = MP + MS, M = 16640;
constexpr int NPADW = 5632;
constexpr float EPS = 1e-6f;
constexpr float LOG2E = 1.4426950408889634f;
constexpr float QSCALE = 0.125f * LOG2E;

constexpr size_t O_Y = 0;
constexpr size_t SZ_PKV = (size_t)MP * 128, SZ_PW = (size_t)NB * 512 * 128, SZ_SKV = (size_t)MS * 128, SZ_SW = (size_t)DB * 512 * 128;
constexpr size_t O_PKC = (size_t)MR * D, O_PVC = O_PKC + SZ_PKV, O_PKS = O_PVC + SZ_PKV, O_PVS = O_PKS + SZ_PKV;
constexpr size_t O_PKW = O_PVS + SZ_PKV, O_PVW = O_PKW + SZ_PW, O_PCONV = O_PVW + SZ_PW;
constexpr size_t O_SKC = O_PCONV + (size_t)NB * 30 * 512, O_SVC = O_SKC + SZ_SKV, O_SKS = O_SVC + SZ_SKV, O_SVS = O_SKS + SZ_SKV;
constexpr size_t O_SKW = O_SVS + SZ_SKV, O_SVW = O_SKW + SZ_SW, O_SCONV = O_SVW + SZ_SW, O_END = O_SCONV + (size_t)DB * 30 * 512;

constexpr size_t MiB = 1u << 20;
constexpr size_t WS_CTL = 0, CTL_ZERO_BYTES = 128 * 1024;
constexpr size_t WS_WIN_T = 2 * MiB, WS_PW_T = 14 * MiB, WS_WPA_T = 15 * MiB, WS_WPB_T = 16 * MiB, WS_WO_T = 17 * MiB;
constexpr size_t WS_W1_T = 19 * MiB;
constexpr size_t WS_W2_T = WS_W1_T + 512 * 1024;
constexpr size_t WS_PEH = WS_W2_T + 16 * 1024;
constexpr size_t WS_KCP = 20 * MiB;
constexpr size_t WS_VCPT = WS_KCP + 256 * 1024;
constexpr size_t WS_KCS = 21 * MiB, WS_VCS = 37 * MiB;
constexpr size_t WS_XN = 64 * MiB, WS_QB = 97 * MiB, WS_KS = 114 * MiB, WS_KW = 119 * MiB, WS_VST = 124 * MiB, WS_VWT = 128 * MiB;
constexpr size_t WS_GA = 132 * MiB, WS_U = 149 * MiB, WS_GB = 166 * MiB, WS_MG = 183 * MiB, WS_GN = 248 * MiB, WS_APW = 251 * MiB, WS_CB = 268 * MiB;
constexpr size_t WS_OA = 285 * MiB, WS_H = 302 * MiB, WS_T1 = 335 * MiB, WS_RSS = 368 * MiB, WS_END = 530 * MiB;
constexpr int CW_BAR = 4096;
constexpr int CW_QATT = 16384;

constexpr int RING_BYTES = 131072, LDSCTL_OFF = RING_BYTES, MISC_OFF = LDSCTL_OFF + 320, LDS_BYTES = 147456;

typedef float f32x2_t __attribute__((ext_vector_type(2))); typedef __bf16 bf16x2_t __attribute__((ext_vector_type(2)));
__device__ __forceinline__ unsigned pk2(float lo, float hi) { f32x2_t v = {lo, hi}; bf16x2_t b = __builtin_convertvector(v, bf16x2_t); return __builtin_bit_cast(unsigned, b); }
__device__ __forceinline__ float bf2f(unsigned short v) { return __uint_as_float((unsigned)v << 16); }
__device__ __forceinline__ float fexp2(float x) { return __builtin_amdgcn_exp2f(x); }
__device__ __forceinline__ float frcp(float x) { return __builtin_amdgcn_rcpf(x); }
__device__ __forceinline__ float sigmoidf_(float x) { return frcp(1.f + fexp2(-x * LOG2E)); }
__device__ __forceinline__ float siluf_(float x) { return x * sigmoidf_(x); }
__device__ __forceinline__ float wave_sum(float v) {
#pragma unroll
    for (int o = 1; o < 64; o <<= 1) v += __shfl_xor(v, o);
    return v;
}
__device__ __forceinline__ int crow(int i, int hi) { return (i & 3) + 8 * (i >> 2) + 4 * hi; }
__device__ __forceinline__ f32x16 mfma32(bf16x8 a, bf16x8 b, f32x16 c) { return __builtin_amdgcn_mfma_f32_32x32x16_bf16(a, b, c, 0, 0, 0); }
__device__ __forceinline__ bf16x8 pack8(float a0, float a1, float a2, float a3, float a4, float a5, float a6, float a7) {
    u32x4 w; w.x = pk2(a0, a1); w.y = pk2(a2, a3); w.z = pk2(a4, a5); w.w = pk2(a6, a7); return __builtin_bit_cast(bf16x8, w);
}
__device__ __forceinline__ bf16x8 pack8v(f32x4 a, f32x4 b) { return pack8(a.x, a.y, a.z, a.w, b.x, b.y, b.z, b.w); }

#define XB_TMO      128
#define XB_XCNT(j)  (256  + 64 * (j))
#define XB_XSUB(j)  (1280 + 64 * (j))
#define XB_XGEN(j)  (2304 + 64 * (j))
#define XB_TOP      3328
#define XB_TOPGEN   3392
#define XCD_BAR_WORDS 3456
#define XB_SPIN_CAP (1u << 18)
__device__ __forceinline__ unsigned xb_ld(unsigned* p)              { return __hip_atomic_load(p, __ATOMIC_RELAXED, __HIP_MEMORY_SCOPE_AGENT); }
__device__ __forceinline__ unsigned xb_add(unsigned* p, unsigned v) { return __hip_atomic_fetch_add(p, v, __ATOMIC_RELAXED, __HIP_MEMORY_SCOPE_AGENT); }
__device__ __forceinline__ unsigned xb_xcc_id() { return (unsigned)__builtin_amdgcn_s_getreg((3 << 11) | 20) & 0xFu; }
#define XB_SPIN(cond, bar) do { unsigned _sp = 0; while (cond) { __builtin_amdgcn_s_sleep(1); \
    if ((++_sp & 255u) == 0u) { if (xb_ld(&(bar)[XB_TMO])) break; if (_sp > XB_SPIN_CAP) { atomicAdd(&(bar)[XB_TMO], 1u); break; } } } } while (0)
struct XcdBarrier { unsigned* bar; unsigned x; volatile LAS unsigned* st; };
__device__ __forceinline__ XcdBarrier xcd_barrier_post(unsigned* bar, volatile LAS unsigned* st) {
    XcdBarrier b; b.bar = bar; b.x = xb_xcc_id(); b.st = st;
    if (threadIdx.x == 0) (void)xb_add(&bar[XB_XCNT(b.x)], 1u);
    return b;
}
__device__ __forceinline__ void xcd_barrier_complete(unsigned* bar, unsigned x, unsigned& nloc, unsigned& nx) {
    const unsigned G = gridDim.x * gridDim.y * gridDim.z;
    unsigned sum, cnt, mine, sp = 0u;
    for (;;) {
        sum = 0u; cnt = 0u; mine = 0u;
#pragma unroll
        for (unsigned j = 0; j < 16; ++j) { const unsigned c = xb_ld(&bar[XB_XCNT(j)]); sum += c; cnt += (c > 0u) ? 1u : 0u; mine = (j == x) ? c : mine; }
        if (sum == G) break;
        __builtin_amdgcn_s_sleep(1);
        if ((++sp & 255u) == 0u) { if (xb_ld(&bar[XB_TMO])) break; if (sp > XB_SPIN_CAP) { atomicAdd(&bar[XB_TMO], 1u); break; } }
    }
    nloc = mine > 0u ? mine : 1u; nx = cnt > 0u ? cnt : 1u;
}
__device__ __forceinline__ void xcd_barrier(const XcdBarrier& b) {
    asm volatile("s_waitcnt vmcnt(0)" ::: "memory");
    __syncthreads();
    if (threadIdx.x == 0) {
        unsigned* bar = b.bar;
        __builtin_amdgcn_s_waitcnt(0);
        unsigned nloc = b.st[0], nx = b.st[1];
        if (nloc == 0u) { xcd_barrier_complete(bar, b.x, nloc, nx); b.st[0] = nloc; b.st[1] = nx; }
        const unsigned old = xb_add(&bar[XB_XSUB(b.x)], 1u);
        const unsigned gen = old / nloc;
        if (old + 1u == (gen + 1u) * nloc) {
            __builtin_amdgcn_fence(__ATOMIC_RELEASE, "agent");
            asm volatile("s_waitcnt vmcnt(0)" ::: "memory");
            const unsigned og = xb_add(&bar[XB_TOP], 1u);
            const unsigned tg = og / nx;
            if (og + 1u == (tg + 1u) * nx) xb_add(&bar[XB_TOPGEN], 1u);
            else XB_SPIN(xb_ld(&bar[XB_TOPGEN]) == tg, bar);
            __builtin_amdgcn_fence(__ATOMIC_ACQUIRE, "agent");
            xb_add(&bar[XB_XGEN(b.x)], 1u);
            asm volatile("s_waitcnt vmcnt(0)" ::: "memory");
        } else {
            XB_SPIN(xb_ld(&bar[XB_XGEN(b.x)]) == gen, bar);
            __builtin_amdgcn_fence(__ATOMIC_ACQUIRE, "agent");
            asm volatile("s_waitcnt vmcnt(0)" ::: "memory");
        }
    }
    __syncthreads();
}

struct Frame {
    LAS unsigned char* lds;
    volatile LAS unsigned* MISC;
    gu32* ctl;
    int tid, lane, wave, vcu, G;
    const float* in[28];
    float* out;
    unsigned char* ws;
};
#define IN_F(k) ((const float*)F.in[k])
enum { I_XP = 0, I_XS, I_CKC, I_CVC, I_CKS, I_CVS, I_CKW, I_CVW, I_SCONV, I_PT, I_LNG, I_WIN, I_PEK, I_W1K, I_W2K, I_PEV, I_W1V, I_W2V, I_DWK, I_DWB, I_CLNG, I_CLNB, I_PWW, I_PWB, I_WPA, I_WPB, I_WO, I_FING };

__device__ __forceinline__ int colmap_in(int n) {
    if (n < 1280) return n;
    if (n < 1792) return 1304 + (n - 1280);
    if (n < 2816) { const int t = (n - 1792) >> 8, w = (n - 1792) & 255; return (w < 128) ? (1816 + 128 * t + w) : (2328 + 128 * t + (w - 128)); }
    if (n < 3328) return 2840 + (n - 2816);
    if (n < 5376) return 3352 + (n - 3328);
    if (n < 5400) return 1280 + (n - 5376);
    return -1;
}

template <bool MAPPED>
__device__ __forceinline__ void p0_transpose_item(const float* W, int ldS, bf16* WT, int ldD, int k0, int n0, LAS float* scr, int lane) {
    int c = n0 + (lane & 31); if (MAPPED) c = colmap_in(c);
    float wv[32];
#pragma unroll
    for (int i = 0; i < 32; ++i) { const int kk = 2 * i + (lane >> 5); wv[i] = (c >= 0) ? W[(size_t)(k0 + kk) * ldS + c] : 0.f; }
#pragma unroll
    for (int i = 0; i < 32; ++i) { const int kk = 2 * i + (lane >> 5); scr[kk * 33 + (lane & 31)] = wv[i]; }
    asm volatile("s_waitcnt lgkmcnt(0)" ::: "memory");
    const int ch = lane & 7;
#pragma unroll
    for (int j = 0; j < 4; ++j) { const int n = (lane >> 3) + 8 * j; const LAS float* s = scr + (8 * ch) * 33 + n;
        u32x4 o; o.x = pk2(s[0 * 33], s[1 * 33]); o.y = pk2(s[2 * 33], s[3 * 33]); o.z = pk2(s[4 * 33], s[5 * 33]); o.w = pk2(s[6 * 33], s[7 * 33]);
        __builtin_nontemporal_store(o, (u32x4*)(WT + (size_t)(n0 + n) * ldD + k0 + 8 * ch)); }
    asm volatile("s_waitcnt lgkmcnt(0)" ::: "memory");
}

constexpr int CMP_BS = 128 * 144;
constexpr int CMP_AS_OFF = 2 * CMP_BS, CMP_AS = 8192;
__device__ __forceinline__ void compress_finalize(Frame& F, f32x16 (&acc)[4], int tz, int bb, int g, int ct, bool samp, int nblk, LAS unsigned char* hs, int r32, int h) {
    const bf16* W2T = (const bf16*)(F.ws + WS_W2_T); const float* PEH = (const float*)(F.ws + WS_PEH);
#pragma unroll
            for (int n = 0; n < 2; ++n) {
                const float pe = PEH[tz * 64 + 32 * n + r32];
                float sh[16];
#pragma unroll
                for (int a = 0; a < 4; ++a) {
                    sh[4 * a] = acc[n + 2][4 * a + 1]; sh[4 * a + 1] = acc[n + 2][4 * a + 2]; sh[4 * a + 2] = acc[n + 2][4 * a + 3];
                    const float nxt = (a < 3) ? acc[n + 2][(a < 3) ? 4 * a + 4 : 0] : 0.f;
                    const float snd = h ? acc[n + 2][4 * a] : nxt;
                    sh[4 * a + 3] = __shfl_xor(snd, 32);
                }
#pragma unroll
                for (int i = 0; i < 16; ++i) { const float hv = pe + acc[n][i] + sh[i]; const float sv = siluf_(hv);
                    *(LAS unsigned short*)(hs + crow(i, h) * 144 + (32 * n + r32) * 2) = (unsigned short)(pk2(sv, 0.f) & 0xffffu); }
            }
            asm volatile("s_waitcnt lgkmcnt(0)" ::: "memory");
            f32x16 o2[2]; o2[0] = (f32x16)(0.f); o2[1] = (f32x16)(0.f);
#pragma unroll
            for (int s = 0; s < 4; ++s) {
                const bf16x8 a = *(const LAS bf16x8*)(hs + r32 * 144 + s * 32 + h * 16);
#pragma unroll
                for (int dt = 0; dt < 2; ++dt) { const bf16x8 b = *(const bf16x8*)(W2T + ((size_t)tz * 64 + 32 * dt + r32) * 64 + 16 * s + 8 * h); o2[dt] = mfma32(a, b, o2[dt]); }
            }
#pragma unroll
            for (int dt = 0; dt < 2; ++dt)
#pragma unroll
                for (int i = 0; i < 16; ++i) {
                    const int row = crow(i, h), bi = 31 * ct + row, d = 32 * dt + r32;
                    if (row < 31 && bi < nblk) {
                        if (samp) __builtin_nontemporal_store(o2[dt][i], (float*)(F.ws + (tz ? WS_VCS : WS_KCS)) + ((size_t)bb * 1024 + bi) * 128 + g * 64 + d);
                        else if (tz == 0) ((bf16*)(F.ws + WS_KCP))[((size_t)(bb * 2 + g) * 128 + bi) * 64 + d] = (bf16)(pk2(o2[dt][i], 0.f) & 0xffffu);
                        else ((bf16*)(F.ws + WS_VCPT))[((size_t)(bb * 2 + g) * 64 + d) * 128 + bi] = (bf16)(pk2(o2[dt][i], 0.f) & 0xffffu);
                    }
                }
}

constexpr int CMP_NT_S = 2 * DB * 2 * 33, CMP_NT_P = 2 * NB * 2 * 5, CMP_NT = CMP_NT_S + CMP_NT_P, CMP_TAIL_CUS = (CMP_NT % 2048 + 7) / 8;
__device__ __forceinline__ void compress_jobs(Frame& F, const int jstart, const int jend) {
    const int lane = F.lane, wave = F.wave, r32 = lane & 31, h = lane >> 5, tid = F.tid, cu = F.vcu, ncu = F.G;
    const bf16* W1T = (const bf16*)(F.ws + WS_W1_T); const bf16* W2T = (const bf16*)(F.ws + WS_W2_T); const float* PEH = (const float*)(F.ws + WS_PEH);
    const int* pt = (const int*)F.in[I_PT];
    LAS unsigned char* lds = F.lds;
    constexpr int CMP_FULL = (CMP_NT / 2048) * 2048;
    static_assert(CMP_FULL <= CMP_NT_S && (CMP_NT_S / 2) % 8 == 0, "full jobs hold sample wave-tiles of a single tensor");
    const int q4 = lane >> 4, pc = lane & 15;
    LAS unsigned char* bdst = lds + (tid >> 2) * 144 + (tid & 3) * 32;
    LAS unsigned char* AS = lds + CMP_AS_OFF + wave * CMP_AS;
    constexpr int nblk = 1023;
    u32x4 breg[2]; f32x4 ar0[8], ar1[8], ar2[8];
    int tz = 0, bb = 0, g = 0, ct = 0, j0 = 0; const float* abase = nullptr; const bf16* bsrc = nullptr; unsigned rb[8];
#define CMP_SETUP(JOB) do { \
        const int wt_ = 8 * (JOB) + wave;                        \
        j0 = (cu * 5 + ((JOB) / ncu) * 3) & 15;                  \
        tz = (8 * (JOB)) / (CMP_NT_S / 2);                       \
        { const int r1 = wt_ % (CMP_NT_S / 2); bb = r1 / 66; const int r2 = r1 % 66; ct = r2 >> 1; g = r2 & 1; } \
        abase = IN_F(tz ? I_CVC : I_CKC) + g * 64 + 4 * pc; \
        _Pragma("unroll") for (int i = 0; i < 8; ++i) { int c = 31 * ct + 4 * i + q4; if (c > 1023) c = 1023; const int page = pt[bb * 128 + (c >> 3)]; rb[i] = (unsigned)((page * 128 + (c & 7) * 16) * 128); } \
        bsrc = W1T + ((size_t)tz * 128 + (tid >> 2)) * 1024 + (tid & 3) * 16; \
        _Pragma("unroll") for (int q = 0; q < 2; ++q) breg[q] = *(const u32x4*)(bsrc + (j0 & 15) * 64 + q * 8); \
        _Pragma("unroll") for (int i = 0; i < 8; ++i) ar0[i] = __builtin_nontemporal_load((const f32x4*)(abase + rb[i] + (j0 & 15) * 128)); \
        _Pragma("unroll") for (int i = 0; i < 8; ++i) ar1[i] = __builtin_nontemporal_load((const f32x4*)(abase + rb[i] + ((j0 + 1) & 15) * 128)); \
        _Pragma("unroll") for (int i = 0; i < 8; ++i) ar2[i] = __builtin_nontemporal_load((const f32x4*)(abase + rb[i] + ((j0 + 2) & 15) * 128)); \
    } while (0)
    const int jlim = (jend < CMP_FULL / 8) ? jend : CMP_FULL / 8;
    int job = jstart;
    if (job < jlim) CMP_SETUP(job);
    while (job < jlim) {
        f32x16 acc[4];
#pragma unroll
        for (int n = 0; n < 4; ++n) acc[n] = (f32x16)(0.f);
        __syncthreads();
#pragma unroll
        for (int q = 0; q < 2; ++q) *(LAS u32x4*)(bdst + q * 16) = breg[q];
#define CMP_SLICE(J, AR) do { \
            __syncthreads(); \
            const int st_ = ((J) & 1) * CMP_BS; \
            if ((J) + 1 < 16) { _Pragma("unroll") for (int q = 0; q < 2; ++q) breg[q] = *(const u32x4*)(bsrc + ((j0 + (J) + 1) & 15) * 64 + q * 8); } \
            _Pragma("unroll") for (int i = 0; i < 8; ++i) *(LAS f32x4*)(AS + (4 * i + q4) * 256 + ((pc ^ ((4 * i + q4) & 15)) * 16)) = AR[i]; \
            if ((J) + 3 < 16) { _Pragma("unroll") for (int i = 0; i < 8; ++i) AR[i] = __builtin_nontemporal_load((const f32x4*)(abase + rb[i] + ((j0 + (J) + 3) & 15) * 128)); } \
            const LAS unsigned char* bl = lds + st_ + r32 * 144 + h * 16; \
            _Pragma("unroll") for (int s = 0; s < 4; ++s) { const f32x4 x0 = *(const LAS f32x4*)(AS + r32 * 256 + (((4 * s + 2 * h) ^ (r32 & 15)) * 16)), x1 = *(const LAS f32x4*)(AS + r32 * 256 + (((4 * s + 2 * h + 1) ^ (r32 & 15)) * 16)); const bf16x8 af = pack8v(x0, x1); \
                _Pragma("unroll") for (int n = 0; n < 4; ++n) { const bf16x8 bf = *(const LAS bf16x8*)(bl + n * 32 * 144 + s * 32); acc[n] = mfma32(af, bf, acc[n]); } } \
            if ((J) + 1 < 16) { LAS unsigned char* bd2 = bdst + (((J) + 1) & 1) * CMP_BS; _Pragma("unroll") for (int q = 0; q < 2; ++q) *(LAS u32x4*)(bd2 + q * 16) = breg[q]; } \
        } while (0)
        for (int j = 0; j < 15; j += 3) { CMP_SLICE(j, ar0); CMP_SLICE(j + 1, ar1); CMP_SLICE(j + 2, ar2); }
        CMP_SLICE(15, ar0);
#undef CMP_SLICE
        const int ftz = tz, fbb = bb, fg = g, fct = ct;
        job += ncu;
        if (job < jlim) CMP_SETUP(job);
        compress_finalize(F, acc, ftz, fbb, fg, fct, true, nblk, AS, r32, h);
    }
#undef CMP_SETUP
    __syncthreads();
}
__device__ __forceinline__ void compress_tail(Frame& F) {
    const int lane = F.lane, wave = F.wave, r32 = lane & 31, h = lane >> 5, cu = F.vcu, ncu = F.G;
    const bf16* W1T = (const bf16*)(F.ws + WS_W1_T);
    const int* pt = (const int*)F.in[I_PT];
    LAS unsigned char* lds = F.lds;
    constexpr int CMP_FULL = (CMP_NT / 2048) * 2048;
    constexpr int nrem = CMP_NT - CMP_FULL;
    for (int base = cu; base < nrem; base += 2 * ncu) {
        const bool two = base + ncu < nrem;
        const int wpt = two ? 4 : 8, sub = two ? (wave >> 2) : 0, kp = two ? (wave & 3) : wave, nsl = 16 / wpt, sl0 = kp * nsl;
        const int wt = CMP_FULL + base + sub * ncu;
        const bool samp = wt < CMP_NT_S;
        int tz, bb, g, ct;
        if (samp) { tz = wt / (CMP_NT_S / 2); const int r1 = wt % (CMP_NT_S / 2); bb = r1 / 66; const int r2 = r1 % 66; ct = r2 >> 1; g = r2 & 1; }
        else { const int w2 = wt - CMP_NT_S; tz = w2 / (CMP_NT_P / 2); const int r1 = w2 % (CMP_NT_P / 2); bb = r1 / 10; const int r2 = r1 % 10; ct = r2 >> 1; g = r2 & 1; }
        const int nchunk = samp ? 1024 : 128, nblk = samp ? 1023 : 127;
        int c = 31 * ct + r32; if (c > nchunk - 1) c = nchunk - 1;
        const float* arow;
        if (samp) { const int page = pt[bb * 128 + (c >> 3)]; arow = IN_F(tz ? I_CVC : I_CKC) + ((size_t)page * 128 + (c & 7) * 16) * 128 + g * 64 + 8 * h; }
        else arow = F.out + (tz ? O_PVC : O_PKC) + ((size_t)bb * SEQ + c * 16) * 128 + g * 64 + 8 * h;
        f32x16 acc[4];
#pragma unroll
        for (int n = 0; n < 4; ++n) acc[n] = (f32x16)(0.f);
        f32x4 arA[8], arB[8];
#define CMP_TLOAD(AR, SL) do { _Pragma("unroll") for (int s = 0; s < 4; ++s) { AR[2 * s] = *(const f32x4*)(arow + (SL) * 128 + 16 * s); AR[2 * s + 1] = *(const f32x4*)(arow + (SL) * 128 + 16 * s + 4); } } while (0)
#define CMP_TMMA(AR, SL) do { const bf16* bp = W1T + ((size_t)tz * 128 + r32) * 1024 + (SL) * 64 + 8 * h; \
            bf16x8 bfr[4][4];                                  \
            _Pragma("unroll") for (int s = 0; s < 4; ++s) _Pragma("unroll") for (int n = 0; n < 4; ++n) bfr[s][n] = *(const bf16x8*)(bp + (size_t)n * 32 * 1024 + 16 * s); \
            _Pragma("unroll") for (int s = 0; s < 4; ++s) { const bf16x8 af = pack8v(AR[2 * s], AR[2 * s + 1]); \
                _Pragma("unroll") for (int n = 0; n < 4; ++n) acc[n] = mfma32(af, bfr[s][n], acc[n]); } } while (0)
        CMP_TLOAD(arA, sl0); CMP_TLOAD(arB, sl0 + 1);
#pragma unroll 1
        for (int jj = 0; jj < nsl; jj += 2) {
            CMP_TMMA(arA, sl0 + jj);     if (jj + 2 < nsl) CMP_TLOAD(arA, sl0 + jj + 2);
            CMP_TMMA(arB, sl0 + jj + 1); if (jj + 3 < nsl) CMP_TLOAD(arB, sl0 + jj + 3);
        }
#undef CMP_TLOAD
#undef CMP_TMMA
        LAS float* R = (LAS float*)lds;
        __syncthreads();
#pragma unroll
        for (int n = 0; n < 4; ++n)
#pragma unroll
            for (int i = 0; i < 16; ++i) (R + wave * 4096 + lane)[(n * 16 + i) * 64] = acc[n][i];
        __syncthreads();
        if (kp == 0) {
#pragma unroll 1
            for (int w = 1; w < wpt; ++w) { const LAS float* Rw = R + (wave + w) * 4096 + lane;
#pragma unroll
                for (int n = 0; n < 4; ++n)
#pragma unroll
                    for (int i = 0; i < 16; ++i) acc[n][i] += Rw[(n * 16 + i) * 64]; }
        }
        __syncthreads();
        if (kp == 0) compress_finalize(F, acc, tz, bb, g, ct, samp, nblk, lds + wave * 16384, r32, h);
    }
    __syncthreads();
}

__device__ __forceinline__ void p0_prologue(Frame& F, const int part, const int cu, const int ncu) {
    const int gw = cu * NWAVES + F.wave, NGW = ncu * NWAVES, lane = F.lane;
    {
        LAS float* scr = (LAS float*)(F.lds + F.wave * 8704);
        constexpr int I_IN = 16 * (NPADW / 32), I_PW = 8 * 16, I_PA = 8 * 32, I_OO = 16 * 32, I_W1 = 16 * 2, I_W2 = 2;
        constexpr int NITEMS = I_IN + I_PW + 2 * I_PA + I_OO + 4 * I_W1 + 2 * I_W2;
        constexpr int I_B = I_IN + I_PW + 4 * I_W1 + 2 * I_W2;
        for (int it = (part == 0 ? 0 : part == 1 ? I_IN : I_B) + gw; it < (part == 0 ? I_IN : part == 1 ? I_B : NITEMS); it += NGW) {
            int r = it;
            if (r < I_IN) { p0_transpose_item<true>(IN_F(I_WIN), 5400, (bf16*)(F.ws + WS_WIN_T), 1024, 64 * (r / (NPADW / 32)), 32 * (r % (NPADW / 32)), scr, lane); continue; } r -= I_IN;
            if (r < I_PW) { p0_transpose_item<false>(IN_F(I_PWW), 512, (bf16*)(F.ws + WS_PW_T), 512, 64 * (r / 16), 32 * (r % 16), scr, lane); continue; } r -= I_PW;
            if (r < 4 * I_W1) { const int tz = r / (2 * I_W1), rr = (r / I_W1) & 1, q = r % I_W1;
                p0_transpose_item<false>(IN_F(tz ? I_W1V : I_W1K) + (size_t)rr * 1024 * 64, 64, (bf16*)(F.ws + WS_W1_T) + ((size_t)tz * 128 + rr * 64) * 1024, 1024, 64 * (q / 2), 32 * (q % 2), scr, lane); continue; } r -= 4 * I_W1;
            if (r < 2 * I_W2) { const int tz = r / I_W2, q = r % I_W2;
              p0_transpose_item<false>(IN_F(tz ? I_W2V : I_W2K), 64, (bf16*)(F.ws + WS_W2_T) + (size_t)tz * 4096, 64, 0, 32 * q, scr, lane); continue; } r -= 2 * I_W2;
            if (r < I_PA) { p0_transpose_item<false>(IN_F(I_WPA), 1024, (bf16*)(F.ws + WS_WPA_T), 512, 64 * (r / 32), 32 * (r % 32), scr, lane); continue; } r -= I_PA;
            if (r < I_PA) { p0_transpose_item<false>(IN_F(I_WPB), 1024, (bf16*)(F.ws + WS_WPB_T), 512, 64 * (r / 32), 32 * (r % 32), scr, lane); continue; } r -= I_PA;
            if (r < I_OO) { p0_transpose_item<false>(IN_F(I_WO), 1024, (bf16*)(F.ws + WS_WO_T), 1024, 64 * (r / 32), 32 * (r % 32), scr, lane); continue; }
        }
    }
    if (part == 1) for (int it = NGW - 1 - gw; it < 128; it += NGW) {
        const int tz = it >> 6, hh = it & 63; const float* pe = IN_F(tz ? I_PEV : I_PEK); const float* w1 = IN_F(tz ? I_W1V : I_W1K);
        float s = 0.f;
        for (int i = 0; i < 32; ++i) { const int k = lane + 64 * i; s += pe[k] * w1[(size_t)k * 64 + hh]; }
        s = wave_sum(s);
        if (lane == 0) ((float*)(F.ws + WS_PEH))[it] = s;
    }
    if (!part) {
        const float* lg = IN_F(I_LNG);
        f32x4 gv[4];
#pragma unroll
        for (int j = 0; j < 4; ++j) gv[j] = *(const f32x4*)(lg + (lane + 64 * j) * 4);
        for (int m0 = gw; m0 < M; m0 += 4 * NGW) {
            f32x4 v[4][4]; float ss[4];
#pragma unroll
            for (int q = 0; q < 4; ++q) { const int m = m0 + q * NGW; ss[q] = 0.f;
                if (m < MR) { const float* xr = (m < MP) ? IN_F(I_XP) + (size_t)m * D : IN_F(I_XS) + (size_t)(m - MP) * D;
#pragma unroll
                    for (int j = 0; j < 4; ++j) v[q][j] = __builtin_nontemporal_load((const f32x4*)(xr + (lane + 64 * j) * 4)); }
                else {
#pragma unroll
                    for (int j = 0; j < 4; ++j) v[q][j] = (f32x4){0.f, 0.f, 0.f, 0.f}; } }
#pragma unroll
            for (int q = 0; q < 4; ++q) {
#pragma unroll
                for (int j = 0; j < 4; ++j) ss[q] += (v[q][j].x * v[q][j].x + v[q][j].y * v[q][j].y) + (v[q][j].z * v[q][j].z + v[q][j].w * v[q][j].w); }
#pragma unroll
            for (int q = 0; q < 4; ++q) { const int m = m0 + q * NGW; if (m >= M) continue;
                const float rstd = 1.0f / sqrtf(wave_sum(ss[q]) * (1.f / D) + EPS);
                u32x2* o8 = (u32x2*)(F.ws + WS_XN + (size_t)m * D * 2) + lane;
#pragma unroll
                for (int j = 0; j < 4; ++j) { const f32x4 y = v[q][j] * rstd * gv[j]; __builtin_nontemporal_store((m < MR) ? (u32x2){pk2(y.x, y.y), pk2(y.z, y.w)} : (u32x2){0u, 0u}, o8 + 64 * j); } }
        }
    }
    if (part == 2) {
        const int gt = cu * NTHR + F.tid, NGT = ncu * NTHR;
        constexpr int W4 = 508 * 128 / 4, C4 = 26 * 512 / 4;
        for (int i0 = gt; i0 < 2 * DB * W4; i0 += 4 * NGT) { f32x4 v[4];
#pragma unroll
            for (int k = 0; k < 4; ++k) { const int i = i0 + k * NGT; if (i < 2 * DB * W4) { const int tz = i / (DB * W4), r = i % (DB * W4), b = r / W4, q = r % W4; v[k] = __builtin_nontemporal_load((const f32x4*)(IN_F(tz ? I_CVW : I_CKW) + ((size_t)b * 512 + 4) * 128) + q); } }
#pragma unroll
            for (int k = 0; k < 4; ++k) { const int i = i0 + k * NGT; if (i < 2 * DB * W4) { const int tz = i / (DB * W4), r = i % (DB * W4), b = r / W4, q = r % W4; __builtin_nontemporal_store(v[k], (f32x4*)(F.out + (tz ? O_SVW : O_SKW) + (size_t)b * 512 * 128) + q); } } }
        for (int i = gt; i < DB * C4; i += NGT) { const int b = i / C4, q = i % C4;
            ((f32x4*)(F.out + O_SCONV + (size_t)b * 30 * 512))[q] = ((const f32x4*)(IN_F(I_SCONV) + ((size_t)b * 30 + 4) * 512))[q]; }
    }
    if (part == 1) {
        const int gt = cu * NTHR + F.tid, NGT = ncu * NTHR;
        for (int i = gt; i < NB * 2 * 64; i += NGT) { ((bf16*)(F.ws + WS_KCP))[((size_t)(i >> 6) * 128 + 127) * 64 + (i & 63)] = 0; ((bf16*)(F.ws + WS_VCPT))[(size_t)i * 128 + 127] = 0; }
        for (int i = gt; i < DB * 128; i += NGT) { ((float*)(F.ws + WS_KCS))[((size_t)(i >> 7) * 1024 + 1023) * 128 + (i & 127)] = 0.f; ((float*)(F.ws + WS_VCS))[((size_t)(i >> 7) * 1024 + 1023) * 128 + (i & 127)] = 0.f; }
    }
}

struct EpiIn {
    static constexpr bool PERM = true, AFTER_DRAIN = false;
    unsigned char* ws; float* out;
    __device__ __forceinline__ void operator()(const pg8::f32x4 (&acc)[2][2][4][2], const pg8::Unit& u, int wr, int wc, int fr, int fq) const {
        const int pn = u.pn;
#pragma unroll
        for (int ai = 0; ai < 2; ++ai)
#pragma unroll
            for (int m = 0; m < 4; ++m) {
                const int r = u.pm * 256 + ai * 128 + wr * 64 + m * 16 + fr;
                const int cl = wc * 32 + 8 * fq;
                if (pn >= 7 && pn <= 10) {
                    const f32x4 a0 = acc[ai][0][m][0], a1 = acc[ai][0][m][1], g0 = acc[ai][1][m][0], g1 = acc[ai][1][m][1];
                    f32x4 u0, u1;
#pragma unroll
                    for (int e = 0; e < 4; ++e) { u0[e] = a0[e] * sigmoidf_(g0[e]); u1[e] = a1[e] * sigmoidf_(g1[e]); }
                    const int ch = 128 * (pn - 7) + cl;
                    *(u32x4*)((bf16*)(ws + WS_U) + (size_t)r * 512 + ch) = (u32x4){pk2(u0.x, u0.y), pk2(u0.z, u0.w), pk2(u1.x, u1.y), pk2(u1.z, u1.w)};
                    float* dst = nullptr;
                    if (r < MP) { const int t = r & (SEQ - 1); if (t >= SEQ - 30) dst = out + O_PCONV + ((size_t)(r >> 11) * 30 + (t - (SEQ - 30))) * 512 + ch; }
                    else if (r < MR) { const int sm = r - MP; dst = out + O_SCONV + ((size_t)(sm >> 2) * 30 + 26 + (sm & 3)) * 512 + ch; }
                    if (dst) { *(f32x4*)dst = u0; *(f32x4*)(dst + 4) = u1; }
                    continue;
                }
#pragma unroll
                for (int bj = 0; bj < 2; ++bj) {
                    const f32x4 v0 = acc[ai][bj][m][0], v1 = acc[ai][bj][m][1];
                    const int c = pn * 256 + bj * 128 + cl;
                    if (pn < 2) {
                        *(u32x4*)((bf16*)(ws + WS_QB) + (size_t)r * 512 + c) = (u32x4){pk2(v0.x * QSCALE, v0.y * QSCALE), pk2(v0.z * QSCALE, v0.w * QSCALE), pk2(v1.x * QSCALE, v1.y * QSCALE), pk2(v1.z * QSCALE, v1.w * QSCALE)};
                    } else if (pn < 5) {
                        const int set = pn - 2;
                        float* dst = nullptr;
                        if (r < MP) {
                            if (set < 2) dst = out + O_PKC + (size_t)(2 * set + bj) * SZ_PKV + (size_t)r * 128 + cl;
                            else { const int t = r & (SEQ - 1); if (t >= SEQ - 512) dst = out + O_PKW + (size_t)bj * SZ_PW + ((size_t)(r >> 11) * 512 + (t - (SEQ - 512))) * 128 + cl; }
                        } else if (r < MR) {
                            const int sm = r - MP;
                            if (set < 2) dst = out + O_SKC + (size_t)(2 * set + bj) * SZ_SKV + (size_t)sm * 128 + cl;
                            else dst = out + O_SKW + (size_t)bj * SZ_SW + ((size_t)(sm >> 2) * 512 + 508 + (sm & 3)) * 128 + cl;
                        }
                        if (dst) { *(f32x4*)dst = v0; *(f32x4*)(dst + 4) = v1; }
                        if (set >= 1) {
                            if (bj == 0) *(u32x4*)((bf16*)(ws + (set == 1 ? WS_KS : WS_KW)) + (size_t)r * 128 + cl) = (u32x4){pk2(v0.x, v0.y), pk2(v0.z, v0.w), pk2(v1.x, v1.y), pk2(v1.z, v1.w)};
                            else if (r < MP) {
                                bf16* vt = (bf16*)(ws + (set == 1 ? WS_VST : WS_VWT)) + ((size_t)(r >> 11) * 128 + cl) * SEQ + (r & (SEQ - 1));
#pragma unroll
                                for (int e = 0; e < 4; ++e) { vt[(size_t)e * SEQ] = (bf16)(pk2(v0[e], 0.f) & 0xffffu); vt[(size_t)(e + 4) * SEQ] = (bf16)(pk2(v1[e], 0.f) & 0xffffu); }
                            }
                        }
                    } else if (pn < 7 || pn == 11 || pn == 12) {
                        bf16* dstb = (pn < 7) ? (bf16*)(ws + WS_GA) + (size_t)r * 512 + (c - 1280) : (bf16*)(ws + WS_GB) + (size_t)r * 512 + (c - 2816);
                        *(u32x4*)dstb = (u32x4){pk2(siluf_(v0.x), siluf_(v0.y)), pk2(siluf_(v0.z), siluf_(v0.w)), pk2(siluf_(v1.x), siluf_(v1.y)), pk2(siluf_(v1.z), siluf_(v1.w))};
                    } else if (pn < 21) {
                        *(u32x4*)((bf16*)(ws + WS_MG) + (size_t)r * 2048 + (c - 3328)) = (u32x4){pk2(sigmoidf_(v0.x), sigmoidf_(v0.y)), pk2(sigmoidf_(v0.z), sigmoidf_(v0.w)), pk2(sigmoidf_(v1.x), sigmoidf_(v1.y)), pk2(sigmoidf_(v1.z), sigmoidf_(v1.w))};
                    } else {
                        if (bj == 0 && wc == 0) { float* dg = (float*)(ws + WS_GN) + (size_t)r * 32 + cl;
                            *(f32x4*)dg = (f32x4){sigmoidf_(v0.x), sigmoidf_(v0.y), sigmoidf_(v0.z), sigmoidf_(v0.w)}; *(f32x4*)(dg + 4) = (f32x4){sigmoidf_(v1.x), sigmoidf_(v1.y), sigmoidf_(v1.z), sigmoidf_(v1.w)}; }
                    }
                }
            }
    }
};

constexpr int CV_TILE = 0, CV_T = 65536, CV_STATS = CV_T + 65536;
__device__ __forceinline__ void conv_load(Frame& F, int u, u32x4 (&v)[8]) {
    const int tid = F.tid;
    const bool samp = u >= 512; const int bb = samp ? u - 512 : u >> 6, t0 = samp ? 0 : 32 * (u & 63);
    const bf16* U = (const bf16*)(F.ws + WS_U);
#pragma unroll
    for (int k = 0; k < 8; ++k) { const int it = tid + k * NTHR; const int i = it >> 6, c8 = (it & 63) * 8; v[k] = (u32x4){0u, 0u, 0u, 0u};
        if (it < 62 * 64) {
            if (samp) {
                if (i < 30) { const float* sp = IN_F(I_SCONV) + ((size_t)bb * 30 + i) * 512 + c8; const f32x4 a = *(const f32x4*)sp, b2 = *(const f32x4*)(sp + 4); v[k] = (u32x4){pk2(a.x, a.y), pk2(a.z, a.w), pk2(b2.x, b2.y), pk2(b2.z, b2.w)}; }
                else if (i < 34) v[k] = *(const u32x4*)(U + (size_t)(MP + bb * 4 + i - 30) * 512 + c8);
            } else { const int t = t0 - 30 + i; if (t >= 0) v[k] = *(const u32x4*)(U + ((size_t)bb * SEQ + t) * 512 + c8); } } }
}
__device__ __forceinline__ void conv_unit(Frame& F, int u, int un, u32x4 (&v)[8], const float (&kw)[31], float bias, float lg, float lb) {
    LAS unsigned short* tile = (LAS unsigned short*)(F.lds + CV_TILE);
    LAS float* T = (LAS float*)(F.lds + CV_T);
    LAS float* stats = (LAS float*)(F.lds + CV_STATS);
    const int tid = F.tid, lane = F.lane, wave = F.wave;
    const bool samp = u >= 512; const int bb = samp ? u - 512 : u >> 6, t0 = samp ? 0 : 32 * (u & 63), nt = samp ? 4 : 32;
    __syncthreads();
#pragma unroll
    for (int k = 0; k < 8; ++k) { const int it = tid + k * NTHR; if (it < 62 * 64) *(LAS u32x4*)(tile + (it >> 6) * 512 + (it & 63) * 8) = v[k]; }
    if (un >= 0) conv_load(F, un, v);
    __syncthreads();
    const int ch = tid;
    for (int hf = 0; hf < 2; ++hf) {
        if (samp && hf) break;
        float x[46];
#pragma unroll
        for (int i = 0; i < 46; ++i) x[i] = bf2f(tile[(16 * hf + i) * 512 + ch]);
        float cv[16];
#pragma unroll
        for (int t = 0; t < 16; ++t) cv[t] = bias;
#pragma unroll
        for (int i = 0; i < 46; ++i) {
#pragma unroll
            for (int t = 0; t < 16; ++t) { const int w = i - t; if (w >= 0 && w < 31) cv[t] += kw[w] * x[i]; } }
#pragma unroll
        for (int t = 0; t < 16; ++t) T[(16 * hf + t) * 512 + ch] = cv[t];
    }
    __syncthreads();
#pragma unroll
    for (int q = 0; q < 4; ++q) { const int t = wave * 4 + q; float s1 = 0.f, s2 = 0.f;
#pragma unroll
        for (int k = 0; k < 8; ++k) { const float v = T[t * 512 + lane + 64 * k]; s1 += v; s2 += v * v; }
        s1 = wave_sum(s1); s2 = wave_sum(s2);
        if (lane == 0) { const float mu = s1 * (1.f / 512.f), var = fmaxf(s2 * (1.f / 512.f) - mu * mu, 0.f); stats[t * 2] = mu; stats[t * 2 + 1] = 1.0f / sqrtf(var + EPS); } }
    __syncthreads();
#pragma unroll
    for (int t = 0; t < 32; ++t) if (t < nt) {
        const float y = (T[t * 512 + ch] - stats[t * 2]) * stats[t * 2 + 1] * lg + lb;
        tile[t * 512 + ch] = (unsigned short)(pk2(siluf_(y), 0.f) & 0xffffu);
    }
    __syncthreads();
    bf16* A = (bf16*)(F.ws + WS_APW);
    for (int it = tid; it < nt * 64; it += NTHR) { const int t = it >> 6, c8 = (it & 63) * 8;
        const size_t m = samp ? (size_t)(MP + bb * 4 + t) : (size_t)bb * SEQ + t0 + t;
        *(u32x4*)(A + m * 512 + c8) = *(const LAS u32x4*)(tile + t * 512 + c8); }
}

struct Soft { f32x16 o0, o1; float m, l; };
__device__ __forceinline__ void soft_init(Soft& s, float m0 = -1e30f) { s.o0 = (f32x16)(0.f); s.o1 = (f32x16)(0.f); s.m = m0; s.l = 0.f; }

constexpr int KT_PITCH = 144, VT_PITCH = 136, KT_BYTES = 64 * KT_PITCH, VT_BYTES = 64 * VT_PITCH, KV_STAGE = KT_BYTES + VT_BYTES;
__device__ __forceinline__ void attn_half_step(Soft& st, f32x16& p, const LAS unsigned char* Vt, int kbase, int kpos, int lo, int hi, bool en, int mm, int r32, int h) {
    if (mm == 2) {
#pragma unroll
        for (int i = 0; i < 16; ++i) { const int kp = kpos + crow(i, h); const bool ok = en && kp >= lo && kp <= hi; p[i] = ok ? p[i] : -INFINITY; }
    }
    float mx = fmaxf(p[0], p[1]);
#pragma unroll
    for (int i = 2; i < 16; ++i) mx = fmaxf(mx, p[i]);
    if (mm == 1) mx = en ? mx : -INFINITY;
    mx = fmaxf(mx, __shfl_xor(mx, 32));
    if (__any(mx > st.m + 16.f)) {
        const float mn = (mx > st.m + 16.f) ? mx : st.m, alpha = fexp2(st.m - mn);
        st.m = mn; st.l *= alpha; st.o0 *= alpha; st.o1 *= alpha;
    }
    if (__any(st.m != 0.f)) {
#pragma unroll
        for (int i = 0; i < 16; ++i) p[i] -= st.m;
    }
#pragma unroll
    for (int i = 0; i < 16; ++i) p[i] = fexp2(p[i]);
    f32x2_t s2 = {p[0], p[1]};
#pragma unroll
    for (int i = 1; i < 8; ++i) s2 += (f32x2_t){p[2 * i], p[2 * i + 1]};
    const float sum = s2.x + s2.y;
    const bool off = (mm == 1) && !en;
    st.l += off ? 0.f : sum;
#pragma unroll
    for (int s = 0; s < 2; ++s) {
        u32x4 w; w.x = pk2(p[8 * s], p[8 * s + 1]); w.y = pk2(p[8 * s + 2], p[8 * s + 3]); w.z = pk2(p[8 * s + 4], p[8 * s + 5]); w.w = pk2(p[8 * s + 6], p[8 * s + 7]);
        if (mm == 1) { w.x = off ? 0u : w.x; w.y = off ? 0u : w.y; w.z = off ? 0u : w.z; w.w = off ? 0u : w.w; }
        const bf16x8 pb = __builtin_bit_cast(bf16x8, w);
        const int ko = (kbase + 16 * s + 4 * h) * 2;
        { const s16x4 a = *(const LAS s16x4*)(Vt + r32 * VT_PITCH + ko), b = *(const LAS s16x4*)(Vt + r32 * VT_PITCH + ko + 16);
          st.o0 = mfma32((bf16x8){a[0], a[1], a[2], a[3], b[0], b[1], b[2], b[3]}, pb, st.o0); }
        { const s16x4 a = *(const LAS s16x4*)(Vt + (32 + r32) * VT_PITCH + ko), b = *(const LAS s16x4*)(Vt + (32 + r32) * VT_PITCH + ko + 16);
          st.o1 = mfma32((bf16x8){a[0], a[1], a[2], a[3], b[0], b[1], b[2], b[3]}, pb, st.o1); }
    }
}
__device__ __forceinline__ void attn_tile_lds(Soft& st, const bf16x8 (&qf)[4], const LAS unsigned char* Kt, const LAS unsigned char* Vt, int kpos0, int lo, int hi, bool en, int mm, int r32, int h) {
    f32x16 p0 = (f32x16)(0.f), p1 = (f32x16)(0.f);
#pragma unroll
    for (int s = 0; s < 4; ++s) { const bf16x8 kf = *(const LAS bf16x8*)(Kt + r32 * KT_PITCH + s * 32 + h * 16); p0 = mfma32(kf, qf[s], p0); }
#pragma unroll
    for (int s = 0; s < 4; ++s) { const bf16x8 kf = *(const LAS bf16x8*)(Kt + (32 + r32) * KT_PITCH + s * 32 + h * 16); p1 = mfma32(kf, qf[s], p1); }
    attn_half_step(st, p0, Vt, 0, kpos0, lo, hi, en, mm, r32, h);
    attn_half_step(st, p1, Vt, 32, kpos0 + 32, lo, hi, en, mm, r32, h);
}
struct KVRegs { u32x4 k, v; };
__device__ __forceinline__ void kv_load(KVRegs& r, const bf16* Kg, int ldk, const bf16* Vg, int ldv, int key0, int tid) {
    const int row = tid >> 3, ch = tid & 7;
    r.k = *(const u32x4*)(Kg + (size_t)(key0 + row) * ldk + ch * 8);
    r.v = *(const u32x4*)(Vg + (size_t)row * ldv + key0 + ch * 8);
}
__device__ __forceinline__ void kv_store(const KVRegs& r, LAS unsigned char* stage, int tid) {
    const int row = tid >> 3, ch = tid & 7;
    *(LAS u32x4*)(stage + row * KT_PITCH + ch * 16) = r.k;
    LAS u32x2* vd = (LAS u32x2*)(stage + KT_BYTES + row * VT_PITCH + ch * 16);
    vd[0] = (u32x2){r.v.x, r.v.y}; vd[1] = (u32x2){r.v.z, r.v.w};
}
template <class EnFn, class ModeFn>
__device__ __forceinline__ void attn_branch_lds(Soft& st, const bf16x8 (&qf)[4], LAS unsigned char* kv, const bf16* Kg, int ldk, const bf16* Vg, int ldv,
                                                int jlo, int jhi, unsigned tilemask, int lo, int hi, const EnFn& en, const ModeFn& mode, int tid, int r32, int h) {
    unsigned todo = tilemask & ((jhi >= 31 ? 0xffffffffu : ((1u << (jhi + 1)) - 1u))) & ~((1u << jlo) - 1u);
    if (!todo) return;
    KVRegs r; int j = __builtin_ctz(todo); todo &= todo - 1u; int buf = 0;
    kv_load(r, Kg, ldk, Vg, ldv, 64 * j, tid);
    __syncthreads();
    kv_store(r, kv, tid);
    for (;;) {
        __syncthreads();
        const int jn = todo ? __builtin_ctz(todo) : -1;
        if (jn >= 0) { todo &= todo - 1u; kv_load(r, Kg, ldk, Vg, ldv, 64 * jn, tid); }
        attn_tile_lds(st, qf, kv + buf * KV_STAGE, kv + buf * KV_STAGE + KT_BYTES, 64 * j, lo, hi, en(j), mode(j), r32, h);
        if (jn < 0) break;
        kv_store(r, kv + (buf ^ 1) * KV_STAGE, tid);
        buf ^= 1; j = jn;
    }
}
__device__ __forceinline__ void soft_finish(f32x16& a0, f32x16& a1, Soft& st, float gate) {
    const float l = st.l + __shfl_xor(st.l, 32);
    const float sc = gate / fmaxf(l, 1e-30f);
    a0 += st.o0 * sc; a1 += st.o1 * sc;
}

constexpr int PA_KV = 0, PA_PST = 2 * KV_STAGE, PA_SC = PA_PST + 128 * 64 * 4, PA_SEL = PA_SC + 32 * 64 * 4, PA_ANY = PA_SEL + 256;
__device__ __forceinline__ void attn_prompt_unit(Frame& F, int b, int g, int qb) {
    const int tid = F.tid, lane = F.lane, wave = F.wave, r32 = lane & 31, h = lane >> 5;
    const int hh = wave >> 1, qh = wave & 1, ql = 32 * qh + r32, q0 = 64 * qb, qpos = q0 + ql;
    const size_t mrow = (size_t)b * SEQ + qpos;
    LAS unsigned char* lds = F.lds;
    LAS unsigned char* kv = lds + PA_KV;
    LAS float* psT = (LAS float*)(lds + PA_PST);
    LAS float* sc = (LAS float*)(lds + PA_SC);
    LAS unsigned* sel = (LAS unsigned*)(lds + PA_SEL);
    LAS unsigned* anysel = (LAS unsigned*)(lds + PA_ANY);
    bf16x8 qf[4];
    { const bf16* qp = (const bf16*)(F.ws + WS_QB) + mrow * 512 + (g * 4 + hh) * 64 + 8 * h;
#pragma unroll
      for (int s = 0; s < 4; ++s) qf[s] = *(const bf16x8*)(qp + 16 * s); }
    const float* gn = (const float*)(F.ws + WS_GN) + mrow * 32 + g * 12 + hh * 3;
    float gc = gn[0], gs = gn[1], gw_ = gn[2];
    f32x16 a0 = (f32x16)(0.f), a1 = (f32x16)(0.f);
    if (tid < 64) sel[tid] = 0u;
    if (tid == 64) anysel[0] = 0u;
    const bf16* Kc = (const bf16*)(F.ws + WS_KCP) + (size_t)(b * 2 + g) * 128 * 64;
    const bf16* Vc = (const bf16*)(F.ws + WS_VCPT) + (size_t)(b * 2 + g) * 64 * 128;
    const int hic = (qpos - 31) >> 4;
    Soft st; soft_init(st, 0.f);
    auto en_all = [](int) { return true; };
    auto mode_full = [](int) { return 2; };
    const int nct = (q0 + 63 >= 31 + 16 * 64) ? 2 : 1;
    attn_branch_lds(st, qf, kv, Kc, 64, Vc, 128, 0, nct - 1, 3u, 0, hic, en_all, mode_full, tid, r32, h);
    const float lc = st.l + __shfl_xor(st.l, 32), mc = st.m, rlc = 1.0f / fmaxf(lc, 1e-30f);
    soft_finish(a0, a1, st, gc);
    if (qb <= 15) { if (tid < 64) sel[tid] = (2u << qb) - 1u; if (tid == 64) anysel[0] = (2u << qb) - 1u; }
    else {
    for (int t = 0; t < 2; ++t) {
        f32x16 p[2]; const bool have = t < nct;
        if (have) {
#pragma unroll
            for (int kh = 0; kh < 2; ++kh) { p[kh] = (f32x16)(0.f);
#pragma unroll
                for (int s = 0; s < 4; ++s) { const bf16x8 kf = *(const LAS bf16x8*)(kv + t * KV_STAGE + (32 * kh + r32) * KT_PITCH + s * 32 + h * 16); p[kh] = mfma32(kf, qf[s], p[kh]); } }
        }
        for (int turn = 0; turn < 4; ++turn) {
            if (turn == hh) {
#pragma unroll
                for (int kh = 0; kh < 2; ++kh)
#pragma unroll
                    for (int i = 0; i < 16; ++i) { const int bi = 64 * t + 32 * kh + crow(i, h);
                        const float pn = (have && bi <= hic) ? fexp2(p[kh][i] - mc) * rlc : 0.f;
                        LAS float* d = psT + bi * 64 + ql; if (turn == 0) *d = pn; else *d += pn; }
            }
            __syncthreads();
        }
    }
    for (int it = 0; it < 4; ++it) { const int q = tid & 63, j = (tid >> 6) + 8 * it; float s = 0.f;
#pragma unroll
        for (int i = 4 * j - 1; i <= 4 * j + 3; ++i) if (i >= 0 && i <= 126) s += psT[i * 64 + q];
        float v = (j == 0 || j == qb || j == qb - 1) ? 1e4f : s; if (j > qb) v = -1.0f;
        sc[j * 64 + q] = v; }
    __syncthreads();
    for (int it = 0; it < 4; ++it) { const int q = tid & 63, j = (tid >> 6) + 8 * it; const float v = sc[j * 64 + q]; int rank = 0;
#pragma unroll
        for (int j2 = 0; j2 < 32; ++j2) { const float w = sc[j2 * 64 + q]; rank += (w > v || (w == v && j2 < j)) ? 1 : 0; }
        if (rank < 16 && j <= qb) { atomicOr((unsigned*)&sel[q], 1u << j); atomicOr((unsigned*)anysel, 1u << j); } }
    }
    __syncthreads();
    const unsigned mysel = sel[ql], tmask = anysel[0];
    soft_init(st, 0.f);
    { const bf16* Ks = (const bf16*)(F.ws + WS_KS) + (size_t)b * SEQ * 128 + g * 64;
      const bf16* Vs = (const bf16*)(F.ws + WS_VST) + (size_t)(b * 2 + g) * 64 * SEQ;
      auto en_sel = [mysel](int j) { return ((mysel >> j) & 1u) != 0u; };
      auto mode_sel = [qb](int j) { return (j == qb) ? 2 : (qb <= 15 ? 0 : 1); };
      attn_branch_lds(st, qf, kv, Ks, 128, Vs, SEQ, 0, qb, tmask, -1, qpos, en_sel, mode_sel, tid, r32, h); }
    soft_finish(a0, a1, st, gs);
    soft_init(st, 0.f);
    { const bf16* Kw = (const bf16*)(F.ws + WS_KW) + (size_t)b * SEQ * 128 + g * 64;
      const bf16* Vw = (const bf16*)(F.ws + WS_VWT) + (size_t)(b * 2 + g) * 64 * SEQ;
      auto mode_win = [qb](int j) { return (j == qb || j == qb - 8) ? 2 : 0; };
      attn_branch_lds(st, qf, kv, Kw, 128, Vw, SEQ, (qb >= 8) ? qb - 8 : 0, qb, 0xffffffffu, qpos - 512, qpos, en_all, mode_win, tid, r32, h); }
    soft_finish(a0, a1, st, gw_);
    const bf16* ga = (const bf16*)(F.ws + WS_GA) + mrow * 512 + (g * 4 + hh) * 64;
    bf16* oa = (bf16*)(F.ws + WS_OA) + mrow * 512 + (g * 4 + hh) * 64;
#pragma unroll
    for (int dh = 0; dh < 2; ++dh)
#pragma unroll
        for (int a = 0; a < 4; ++a) { const int d = 32 * dh + 8 * a + 4 * h; const u32x2 gv = *(const u32x2*)(ga + d);
            const f32x16& o = dh ? a1 : a0;
            const float x0 = o[4 * a] * __uint_as_float(gv.x << 16), x1 = o[4 * a + 1] * __uint_as_float(gv.x & 0xffff0000u), x2 = o[4 * a + 2] * __uint_as_float(gv.y << 16), x3 = o[4 * a + 3] * __uint_as_float(gv.y & 0xffff0000u);
            *(u32x2*)(oa + d) = (u32x2){pk2(x0, x1), pk2(x2, x3)}; }
    __syncthreads();
}

__device__ __forceinline__ void attn_half_f32(Soft& st, const bf16x8 (&qf)[4], const float* kb, const float* vb, int nrows, int kpos0, int lo, int hi, bool en,
                                              LAS float* sdump, int kidx0, int r32, int h) {
    f32x16 p = (f32x16)(0.f);
    { const int kr = (r32 < nrows) ? r32 : nrows - 1; const float* kp = kb + (size_t)kr * 128 + 8 * h;
      f32x4 kq[8];
#pragma unroll
      for (int s = 0; s < 4; ++s) { kq[2 * s] = *(const f32x4*)(kp + 16 * s); kq[2 * s + 1] = *(const f32x4*)(kp + 16 * s + 4); }
#pragma unroll
      for (int s = 0; s < 4; ++s) p = mfma32(pack8v(kq[2 * s], kq[2 * s + 1]), qf[s], p); }
    float vv[2][2][8];
#pragma unroll
    for (int dh = 0; dh < 2; ++dh)
#pragma unroll
        for (int s = 0; s < 2; ++s)
#pragma unroll
            for (int e = 0; e < 8; ++e) { int kr = 16 * s + 8 * (e >> 2) + 4 * h + (e & 3); kr = (kr < nrows) ? kr : nrows - 1; vv[dh][s][e] = vb[(size_t)kr * 128 + 32 * dh + r32]; }
    float mx = -INFINITY;
#pragma unroll
    for (int i = 0; i < 16; ++i) { const int kp = kpos0 + crow(i, h); const bool ok = en && kp >= lo && kp <= hi; p[i] = ok ? p[i] : -INFINITY; mx = fmaxf(mx, p[i]); }
    if (kidx0 >= 0 && r32 < 16) {
#pragma unroll
        for (int i = 0; i < 16; ++i) sdump[(kidx0 + crow(i, h)) * 16 + r32] = p[i];
    }
    mx = fmaxf(mx, __shfl_xor(mx, 32));
    const float mn = fmaxf(st.m, mx), alpha = fexp2(st.m - mn); st.m = mn;
    float sum = 0.f;
#pragma unroll
    for (int i = 0; i < 16; ++i) { p[i] = fexp2(p[i] - mn); sum += p[i]; }
    st.l = st.l * alpha + sum; st.o0 *= alpha; st.o1 *= alpha;
#pragma unroll
    for (int s = 0; s < 2; ++s) {
        const bf16x8 pb = pack8(p[8 * s], p[8 * s + 1], p[8 * s + 2], p[8 * s + 3], p[8 * s + 4], p[8 * s + 5], p[8 * s + 6], p[8 * s + 7]);
        st.o0 = mfma32(pack8(vv[0][s][0], vv[0][s][1], vv[0][s][2], vv[0][s][3], vv[0][s][4], vv[0][s][5], vv[0][s][6], vv[0][s][7]), pb, st.o0);
        st.o1 = mfma32(pack8(vv[1][s][0], vv[1][s][1], vv[1][s][2], vv[1][s][3], vv[1][s][4], vv[1][s][5], vv[1][s][6], vv[1][s][7]), pb, st.o1);
    }
}
constexpr int SA_SS = 0;
constexpr int SA_WP = 65536;
constexpr int SA_WP_STRIDE = (64 * 16 + 32) * 4;
constexpr int SA_OUT = SA_WP + 8 * SA_WP_STRIDE;
constexpr int SA_ML = SA_OUT + 4096;
constexpr int SA_SCS = SA_ML + 128;
constexpr int SA_SEL = SA_SCS + 4 * 260 * 4;
constexpr int SA_LIST = SA_SEL + 4 * 260;
constexpr int SA_GT = SA_LIST + 296;
constexpr int SA_END = SA_GT + 192;
static_assert(SA_END <= RING_BYTES, "sample attention LDS map");
__device__ __forceinline__ void sample_combine(Frame& F, Soft& st, int br, bool first, bool want_ml, int r32, int h) {
    LAS unsigned char* lds = F.lds; const int wave = F.wave, tid = F.tid;
    LAS float* wp = (LAS float*)(lds + SA_WP + wave * SA_WP_STRIDE);
    const float ltot = st.l + __shfl_xor(st.l, 32);
    if (r32 < 16) {
#pragma unroll
        for (int i = 0; i < 16; ++i) { wp[crow(i, h) * 16 + r32] = st.o0[i]; wp[(32 + crow(i, h)) * 16 + r32] = st.o1[i]; }
        if (h == 0) { wp[1024 + r32] = st.m; wp[1040 + r32] = ltot; }
    }
    __syncthreads();
    LAS float* OUT = (LAS float*)(lds + SA_OUT); LAS float* ML = (LAS float*)(lds + SA_ML); const LAS float* GT = (const LAS float*)(lds + SA_GT);
    for (int e = tid; e < 1024; e += NTHR) { const int col = e & 15, d = e >> 4;
        float mm = -1e30f;
#pragma unroll
        for (int w = 0; w < 8; ++w) mm = fmaxf(mm, ((const LAS float*)(lds + SA_WP + w * SA_WP_STRIDE))[1024 + col]);
        float L = 0.f, O = 0.f;
#pragma unroll
        for (int w = 0; w < 8; ++w) { const LAS float* q = (const LAS float*)(lds + SA_WP + w * SA_WP_STRIDE); const float f = fexp2(q[1024 + col] - mm); L += q[1040 + col] * f; O += q[d * 16 + col] * f; }
        const float v = GT[col * 3 + br] * O / fmaxf(L, 1e-30f);
        if (first) OUT[col * 64 + d] = v; else OUT[col * 64 + d] += v;
        if (want_ml && d == 0) { ML[col * 2] = mm; ML[col * 2 + 1] = 1.0f / fmaxf(L, 1e-30f); }
    }
    __syncthreads();
}
__device__ __forceinline__ void attn_sample_unit(Frame& F, int b, int g) {
    const int tid = F.tid, lane = F.lane, wave = F.wave, r32 = lane & 31, h = lane >> 5;
    const int col = r32 & 15, qi = col >> 2, hh = col & 3, qpos = PAST + qi;
    const size_t mrow = (size_t)MP + b * 4 + qi;
    LAS unsigned char* lds = F.lds;
    LAS float* SS = (LAS float*)(lds + SA_SS); LAS float* ML = (LAS float*)(lds + SA_ML); LAS float* SCS = (LAS float*)(lds + SA_SCS);
    LAS unsigned char* SEL = lds + SA_SEL; LAS int* LIST = (LAS int*)(lds + SA_LIST); LAS float* GT = (LAS float*)(lds + SA_GT);
    bf16x8 qf[4];
    { const bf16* qp = (const bf16*)(F.ws + WS_QB) + mrow * 512 + (g * 4 + hh) * 64 + 8 * h;
#pragma unroll
      for (int s = 0; s < 4; ++s) qf[s] = *(const bf16x8*)(qp + 16 * s); }
    __syncthreads();
    if (tid < 48) { const int c = tid / 3, br = tid % 3; GT[tid] = ((const float*)(F.ws + WS_GN))[((size_t)MP + b * 4 + (c >> 2)) * 32 + g * 12 + (c & 3) * 3 + br];
    }
    __syncthreads();
    const int* pt = (const int*)F.in[I_PT] + b * 128;
    Soft st;
    soft_init(st);
    { const float* kc = (const float*)(F.ws + WS_KCS) + (size_t)b * 1024 * 128 + g * 64; const float* vc = (const float*)(F.ws + WS_VCS) + (size_t)b * 1024 * 128 + g * 64;
      for (int ht = wave; ht < 32; ht += 8)
          attn_half_f32(st, qf, kc + (size_t)ht * 32 * 128, vc + (size_t)ht * 32 * 128, 32, 32 * ht, 0, 1022, true, SS, 32 * ht, r32, h); }
    sample_combine(F, st, 0, true, true, r32, h);
    if (tid < 4) { SCS[tid * 260 + 256] = 1e4f; SEL[tid * 260 + 256] = 1; }
    for (int e = tid; e < 4 * 256; e += NTHR) { const int q = e >> 8, j = e & 255; float s = 0.f;
        for (int i = 4 * j - 1; i <= 4 * j + 3; ++i) if (i >= 0 && i <= 1022) {
#pragma unroll
            for (int x = 0; x < 4; ++x) { const int c = q * 4 + x; s += fexp2(SS[i * 16 + c] - ML[c * 2]) * ML[c * 2 + 1]; } }
        SCS[q * 260 + j] = (j == 0 || j >= 255) ? 1e4f : s; }
    __syncthreads();
    for (int e = tid; e < 4 * 256; e += NTHR) { const int q = e >> 8, j = e & 255; const float v = SCS[q * 260 + j]; int rank = 0;
        for (int j2 = 0; j2 < 257; ++j2) { const float w = SCS[q * 260 + j2]; rank += (w > v || (w == v && j2 < j)) ? 1 : 0; }
        SEL[q * 260 + j] = (rank < 16) ? 1 : 0; }
    __syncthreads();
    if (wave == 0) { int cnt = 0;
        for (int base = 0; base < 257; base += 64) { const int j = base + lane;
            const bool f = (j < 257) && ((SEL[j] | SEL[260 + j] | SEL[520 + j] | SEL[780 + j]) != 0);
            const unsigned long long mk = __ballot(f);
            if (f) LIST[1 + cnt + __popcll(mk & ((1ull << lane) - 1ull))] = j;
            cnt += __popcll(mk); }
        if (lane == 0) LIST[0] = cnt; }
    __syncthreads();
    const int nsel = LIST[0];
    soft_init(st);
    for (int idx = wave; idx < 2 * nsel; idx += 8) { const int j = LIST[1 + (idx >> 1)], kh = idx & 1; const bool en = SEL[qi * 260 + j] != 0;
        if (j < 256) { const size_t ro = ((size_t)pt[j >> 1] * 128 + (j & 1) * 64 + 32 * kh) * 128 + g * 64;
            attn_half_f32(st, qf, IN_F(I_CKS) + ro, IN_F(I_CVS) + ro, 32, 64 * j + 32 * kh, 0, qpos, en, SS, -1, r32, h); }
        else if (kh == 0) { const size_t ro = (size_t)(b * 4) * 128 + g * 64;
            attn_half_f32(st, qf, F.out + O_SKS + ro, F.out + O_SVS + ro, 4, PAST, 0, qpos, en, SS, -1, r32, h); } }
    sample_combine(F, st, 1, false, false, r32, h);
    soft_init(st);
    for (int idx = wave; idx < 17; idx += 8) {
        if (idx < 16) { const size_t ro = ((size_t)b * 512 + 32 * idx) * 128 + g * 64;
            attn_half_f32(st, qf, IN_F(I_CKW) + ro, IN_F(I_CVW) + ro, 32, PAST - 512 + 32 * idx, qpos - 512, qpos, true, SS, -1, r32, h); }
        else { const size_t ro = ((size_t)b * 512 + 508) * 128 + g * 64;
            attn_half_f32(st, qf, F.out + O_SKW + ro, F.out + O_SVW + ro, 4, PAST, qpos - 512, qpos, true, SS, -1, r32, h); } }
    sample_combine(F, st, 2, false, false, r32, h);
    { const LAS float* OUT = (const LAS float*)(lds + SA_OUT);
      for (int e = tid; e < 1024; e += NTHR) { const int c = e >> 6, d = e & 63; const size_t m = (size_t)MP + b * 4 + (c >> 2); const int cc = (g * 4 + (c & 3)) * 64 + d;
          ((bf16*)(F.ws + WS_OA))[m * 512 + cc] = (bf16)(pk2(OUT[c * 64 + d] * bf2f(((const bf16*)(F.ws + WS_GA))[m * 512 + cc]), 0.f) & 0xffffu);
      } }
    __syncthreads();
}

__device__ __forceinline__ void unpack8(const u32x4 w, float (&f)[8]) {
    f[0] = __uint_as_float(w.x << 16); f[1] = __uint_as_float(w.x & 0xffff0000u); f[2] = __uint_as_float(w.y << 16); f[3] = __uint_as_float(w.y & 0xffff0000u);
    f[4] = __uint_as_float(w.z << 16); f[5] = __uint_as_float(w.z & 0xffff0000u); f[6] = __uint_as_float(w.w << 16); f[7] = __uint_as_float(w.w & 0xffff0000u);
}
template <int MODE> struct EpiMul {
    static constexpr bool PERM = true, AFTER_DRAIN = false;
    unsigned char* ws; const float* bias;
    __device__ __forceinline__ void operator()(const pg8::f32x4 (&acc)[2][2][4][2], const pg8::Unit& u, int wr, int wc, int fr, int fq) const {
#pragma unroll
        for (int ai = 0; ai < 2; ++ai)
#pragma unroll
            for (int m = 0; m < 4; ++m) { const size_t r = (size_t)u.pm * 256 + ai * 128 + wr * 64 + m * 16 + fr;
#pragma unroll
                for (int bj = 0; bj < 2; ++bj) { const int c = u.pn * 256 + bj * 128 + wc * 32 + 8 * fq;
                    float v[8]; const pg8::f32x4 v0 = acc[ai][bj][m][0], v1 = acc[ai][bj][m][1];
                    v[0] = v0.x; v[1] = v0.y; v[2] = v0.z; v[3] = v0.w; v[4] = v1.x; v[5] = v1.y; v[6] = v1.z; v[7] = v1.w;
                    float gt[8];
                    if (MODE == 0) { unpack8(*(const u32x4*)((const bf16*)(ws + WS_GB) + r * 512 + c), gt); const f32x4 b0 = *(const f32x4*)(bias + c), b1 = *(const f32x4*)(bias + c + 4);
                        v[0] += b0.x; v[1] += b0.y; v[2] += b0.z; v[3] += b0.w; v[4] += b1.x; v[5] += b1.y; v[6] += b1.z; v[7] += b1.w; }
                    else unpack8(*(const u32x4*)((const bf16*)(ws + WS_MG) + r * 2048 + (MODE == 2 ? 1024 : 0) + c), gt);
#pragma unroll
                    for (int e = 0; e < 8; ++e) v[e] *= gt[e];
                    bf16* dst = (MODE == 0) ? (bf16*)(ws + WS_CB) + r * 512 + c : (MODE == 1) ? (bf16*)(ws + WS_T1) + r * 1024 + c : (bf16*)(ws + WS_H) + r * 1024 + c;
                    if (MODE == 2) { float t[8]; unpack8(*(const u32x4*)((const bf16*)(ws + WS_T1) + r * 1024 + c), t);
#pragma unroll
                        for (int e = 0; e < 8; ++e) v[e] += t[e]; }
                    *(u32x4*)dst = (u32x4){pk2(v[0], v[1]), pk2(v[2], v[3]), pk2(v[4], v[5]), pk2(v[6], v[7])}; } }
    }
};
struct PairOrder {
    pg8::StaticOrder S;
    __device__ __forceinline__ bool next(int i, pg8::Unit& u) const { pg8::Unit b; if (!S.next(i >> 1, b)) return false;
        if (i & 1) { u.pm = b.pm; u.pn = b.pn + 4; } else { u.pm = b.pm + 68; u.pn = b.pn; } return true; }
    __device__ __forceinline__ void a_ready(const pg8::Unit&) const {}
    __device__ __forceinline__ void done(const pg8::Unit&) const {}
};
struct EpiMulAB {
    static constexpr bool PERM = true, AFTER_DRAIN = false;
    unsigned char* ws;
    __device__ __forceinline__ void operator()(const pg8::f32x4 (&acc)[2][2][4][2], const pg8::Unit& u, int wr, int wc, int fr, int fq) const {
        if (u.pn >= 4) { asm volatile("s_waitcnt vmcnt(0)" ::: "memory");
            const pg8::Unit v{u.pm, u.pn - 4}; EpiMul<2>{ws, nullptr}(acc, v, wr, wc, fr, fq); }
        else { const pg8::Unit v{u.pm - 68, u.pn}; EpiMul<1>{ws, nullptr}(acc, v, wr, wc, fr, fq); }
    }
};
struct EpiOut {
    static constexpr bool PERM = true, AFTER_DRAIN = false;
    unsigned char* ws; float* out; const float* xp; const float* xs;
    __device__ __forceinline__ void operator()(const pg8::f32x4 (&acc)[2][2][4][2], const pg8::Unit& u, int wr, int wc, int fr, int fq) const {
#pragma unroll
        for (int ai = 0; ai < 2; ++ai)
#pragma unroll
            for (int m = 0; m < 4; ++m) { const int r = u.pm * 256 + ai * 128 + wr * 64 + m * 16 + fr; const bool ok = r < MR;
                const float* xr = (r < MP) ? xp + (size_t)r * D : xs + (size_t)(ok ? r - MP : 0) * D;
                float ss = 0.f;
#pragma unroll
                for (int bj = 0; bj < 2; ++bj) { const int c = u.pn * 256 + bj * 128 + wc * 32 + 8 * fq;
                    f32x4 o0 = acc[ai][bj][m][0], o1 = acc[ai][bj][m][1];
                    if (ok) { o0 += *(const f32x4*)(xr + c); o1 += *(const f32x4*)(xr + c + 4);
                        *(u32x4*)((bf16*)(ws + WS_T1) + (size_t)r * D + c) = (u32x4){pk2(o0.x, o0.y), pk2(o0.z, o0.w), pk2(o1.x, o1.y), pk2(o1.z, o1.w)}; }
                    ss += (o0.x * o0.x + o0.y * o0.y) + (o0.z * o0.z + o0.w * o0.w) + (o1.x * o1.x + o1.y * o1.y) + (o1.z * o1.z + o1.w * o1.w); }
                ss += __shfl_xor(ss, 16); ss += __shfl_xor(ss, 32);
                if (fq == 0) ((float*)(ws + WS_RSS))[(size_t)r * 16 + u.pn * 4 + wc] = ss; }
    }
};

constexpr size_t WS_RSSS = WS_RSS + 1100 * 1024;
__device__ __forceinline__ f32x16 wave_tile_partial(const bf16* A, int lda, const bf16* Bt, int ldb, int k0, int ksteps, int r32, int h) {
    f32x16 acc = (f32x16)(0.f);
    const bf16* ap = A + (size_t)r32 * lda + k0 + 8 * h; const bf16* bp = Bt + (size_t)r32 * ldb + k0 + 8 * h;
#pragma unroll 8
    for (int s = 0; s < ksteps; ++s) { const bf16x8 a = *(const bf16x8*)(ap + 16 * s), b = *(const bf16x8*)(bp + 16 * s); acc = mfma32(a, b, acc); }
    return acc;
}
__device__ __forceinline__ void sample_rows_p4(Frame& F) {
    if (F.vcu >= 128) return;
    const int lane = F.lane, wave = F.wave, r32 = lane & 31, h = lane >> 5, tid = F.tid;
    const int rg = F.vcu >> 5, cg = F.vcu & 31, row0 = MP + 32 * rg, col0 = 32 * cg;
    LAS float* P = (LAS float*)F.lds;
    float ga[2], gb[2];
#pragma unroll
    for (int q = 0; q < 2; ++q) { const int e = tid + q * NTHR; const int i = e >> 6, ln = e & 63; const size_t row = row0 + crow(i, ln >> 5); const int col = col0 + (ln & 31);
        const bf16* mg = (const bf16*)(F.ws + WS_MG) + row * 2048 + col; ga[q] = bf2f(mg[0]); gb[q] = bf2f(mg[1024]); }
    const f32x16 a1 = wave_tile_partial((const bf16*)(F.ws + WS_OA) + (size_t)row0 * 512, 512, (const bf16*)(F.ws + WS_WPA_T) + (size_t)col0 * 512, 512, 64 * wave, 4, r32, h);
    const f32x16 a2 = wave_tile_partial((const bf16*)(F.ws + WS_CB) + (size_t)row0 * 512, 512, (const bf16*)(F.ws + WS_WPB_T) + (size_t)col0 * 512, 512, 64 * wave, 4, r32, h);
    __syncthreads();
#pragma unroll
    for (int i = 0; i < 16; ++i) { P[(wave * 2) * 1024 + i * 64 + lane] = a1[i]; P[(wave * 2 + 1) * 1024 + i * 64 + lane] = a2[i]; }
    __syncthreads();
#pragma unroll
    for (int q = 0; q < 2; ++q) { const int e = tid + q * NTHR; float s1 = 0.f, s2 = 0.f;
#pragma unroll
        for (int w = 0; w < 8; ++w) { s1 += P[(w * 2) * 1024 + e]; s2 += P[(w * 2 + 1) * 1024 + e]; }
        const int i = e >> 6, ln = e & 63; const size_t row = row0 + crow(i, ln >> 5); const int col = col0 + (ln & 31);
        ((bf16*)(F.ws + WS_H))[row * 1024 + col] = (bf16)(pk2(ga[q] * s1 + gb[q] * s2, 0.f) & 0xffffu); }
    __syncthreads();
}
__device__ __forceinline__ void sample_rows_p5(Frame& F) {
    if (F.vcu >= 128) return;
    const int lane = F.lane, wave = F.wave, r32 = lane & 31, h = lane >> 5, tid = F.tid;
    const int rg = F.vcu >> 5, cg = F.vcu & 31, row0 = MP + 32 * rg, col0 = 32 * cg;
    LAS float* P = (LAS float*)F.lds;
    float xr[2];
#pragma unroll
    for (int q = 0; q < 2; ++q) { const int e = tid + q * NTHR; const int i = e >> 6, ln = e & 63; xr[q] = IN_F(I_XS)[(size_t)(32 * rg + crow(i, ln >> 5)) * D + col0 + (ln & 31)]; }
    const f32x16 a1 = wave_tile_partial((const bf16*)(F.ws + WS_H) + (size_t)row0 * 1024, 1024, (const bf16*)(F.ws + WS_WO_T) + (size_t)col0 * 1024, 1024, 128 * wave, 8, r32, h);
    __syncthreads();
#pragma unroll
    for (int i = 0; i < 16; ++i) P[wave * 1024 + i * 64 + lane] = a1[i];
    __syncthreads();
#pragma unroll
    for (int q = 0; q < 2; ++q) { const int e = tid + q * NTHR; float s1 = 0.f;
#pragma unroll
        for (int w = 0; w < 8; ++w) s1 += P[w * 1024 + e];
        const int i = e >> 6, ln = e & 63; const int srow = 32 * rg + crow(i, ln >> 5), col = col0 + (ln & 31);
        const float o = xr[q] + s1;
        ((bf16*)(F.ws + WS_T1))[(size_t)(MP + srow) * D + col] = (bf16)(pk2(o, 0.f) & 0xffffu);
        float ss = o * o;
        ss += __shfl_xor(ss, 1); ss += __shfl_xor(ss, 2); ss += __shfl_xor(ss, 4); ss += __shfl_xor(ss, 8); ss += __shfl_xor(ss, 16);
        if ((ln & 31) == 0) ((float*)(F.ws + WS_RSSS))[srow * 32 + cg] = ss; }
    __syncthreads();
}

constexpr int N_PHASES = 7;
struct Args { const void* in[28]; float* out; unsigned char* ws; int ph_lo, ph_hi; };
__global__ void __launch_bounds__(NTHR, 2) nsa_fwd(Args args) {
    extern __shared__ __attribute__((aligned(16))) unsigned char lds_raw[];
    Frame F;
    F.lds = (LAS unsigned char*)lds_raw;
    F.MISC = (volatile LAS unsigned*)(F.lds + MISC_OFF);
    F.tid = threadIdx.x; F.lane = F.tid & 63; F.wave = __builtin_amdgcn_readfirstlane(F.tid >> 6);
    F.G = gridDim.x; { const int bx = blockIdx.x; F.vcu = (F.G % 8 == 0) ? (bx % 8) * (F.G / 8) + bx / 8 : bx; }
#pragma unroll
    for (int i = 0; i < 28; ++i) F.in[i] = (const float*)args.in[i];
    F.out = args.out; F.ws = args.ws; F.ctl = (gu32*)(args.ws + WS_CTL);
    for (int u = F.tid; u < (LDS_BYTES - LDSCTL_OFF) / 4; u += NTHR) ((LAS unsigned*)(F.lds + LDSCTL_OFF))[u] = 0u;
    __syncthreads();
    const int lo = args.ph_lo, hi = args.ph_hi;
    const bool multi = (hi - lo) > 1;
    XcdBarrier bar; bar.bar = (unsigned*)(F.ctl + CW_BAR); bar.x = 0; bar.st = nullptr;
    if (multi) bar = xcd_barrier_post((unsigned*)(F.ctl + CW_BAR), F.MISC + 8);
#define IN(k) (lo <= (k) && (k) < hi)
#define BOTH(k) (IN(k) && ((k) + 1) < hi)
#define GRID_BAR() xcd_barrier(bar)

    if (IN(0)) { p0_prologue(F, 0, F.vcu, F.G); if (BOTH(0)) GRID_BAR(); }

    if (IN(1)) {
        pg8::Gemm g{(const pg8::bf16_t*)(F.ws + WS_XN), (const pg8::bf16_t*)(F.ws + WS_WIN_T), M, NPADW, D}; pg8::StaticOrder S; S.init(M, NPADW, F.G, (int)blockIdx.x);
        EpiIn E{F.ws, F.out};
        pg8::gemm_phase<EpiIn, pg8::StaticOrder, true, true>(F.lds, g, S, E);
        { const int nlast = S.nwg % F.G;
          if (nlast == 0) p0_prologue(F, 1, F.vcu, F.G); else if ((int)blockIdx.x >= nlast) { __syncthreads(); p0_prologue(F, 1, (int)blockIdx.x - nlast, F.G - nlast); } }
        if (BOTH(1)) GRID_BAR();
    }

    if (IN(2)) {
        const int cls = F.vcu % 3;
        auto conv_all = [&]() __attribute__((always_inline)) {
            float kw[31];
#pragma unroll
            for (int w = 0; w < 31; ++w) kw[w] = IN_F(I_DWK)[w * 512 + F.tid];
            const float cbias = IN_F(I_DWB)[F.tid], clg = IN_F(I_CLNG)[F.tid], clb = IN_F(I_CLNB)[F.tid];
            u32x4 cvv[8];
            int u = F.G - 1 - F.vcu;
            if (u < 512 + DB) conv_load(F, u, cvv);
            while (u < 512 + DB) { const int un = u + F.G; const bool pre = un < 512;
                conv_unit(F, u, pre ? un : -1, cvv, kw, cbias, clg, clb);
                if (!pre && un < 512 + DB) conv_load(F, un, cvv);
                u = un; }
            __syncthreads();
        };
        if (cls == 0) conv_all();
        compress_jobs(F, F.vcu, F.vcu + 1);
        if (cls == 1) conv_all();
        compress_jobs(F, F.vcu + F.G, 0x7fffffff);
        if (cls == 2) conv_all();
        compress_tail(F);
        if (BOTH(2)) GRID_BAR();
    }

    if (IN(3)) {
        constexpr int NSAMP = 2 * DB;
        const bool samp_cu = (F.G >= 4 * NSAMP) ? ((F.vcu & 3) == 0 && (F.vcu >> 2) < NSAMP) : (F.vcu < NSAMP);
        const int samp_id = (F.G >= 4 * NSAMP) ? (F.vcu >> 2) : F.vcu;
        const int gemm_id = (F.G >= 4 * NSAMP) ? ((F.vcu >> 2) < NSAMP ? F.vcu - (F.vcu >> 2) - 1 : F.vcu - NSAMP) : F.vcu - NSAMP;
        if (samp_cu) { attn_sample_unit(F, samp_id >> 1, samp_id & 1); }
        else {
            pg8::Gemm g{(const pg8::bf16_t*)(F.ws + WS_APW), (const pg8::bf16_t*)(F.ws + WS_PW_T), M, 512, 512}; pg8::StaticOrder S; S.init(M, 512, F.G - NSAMP, gemm_id);
            EpiMul<0> E{F.ws, IN_F(I_PWB)};
            pg8::gemm_phase<EpiMul<0>, pg8::StaticOrder, true, true>(F.lds, g, S, E);
        }
        int item;
        for (;;) {
            __syncthreads();
            if (F.tid == 0) F.MISC[0] = __hip_atomic_fetch_add((unsigned*)(F.ctl + CW_QATT), 1u, __ATOMIC_RELAXED, __HIP_MEMORY_SCOPE_AGENT);
            __syncthreads();
            item = (int)F.MISC[0];
            if (item >= 512) break;
            attn_prompt_unit(F, (item & 15) >> 1, item & 1, 31 - (item >> 4));
        }
        while (item < 512 + 2 * F.G) {
            p0_prologue(F, 2, item - 512, 2 * F.G);
            __syncthreads();
            if (F.tid == 0) F.MISC[0] = __hip_atomic_fetch_add((unsigned*)(F.ctl + CW_QATT), 1u, __ATOMIC_RELAXED, __HIP_MEMORY_SCOPE_AGENT);
            __syncthreads();
            item = (int)F.MISC[0];
        }
        if (BOTH(3)) GRID_BAR();
    }

    if (IN(4)) {
        sample_rows_p4(F);
        static_assert(WS_OA - WS_CB == (size_t)68 * 256 * 512 * 2 && WS_WPB_T - WS_WPA_T == (size_t)4 * 256 * 512 * 2, "stacked operand layout");
        PairOrder S; S.S.init(MP, D, F.G, (int)blockIdx.x);
        pg8::Gemm g{(const pg8::bf16_t*)(F.ws + WS_CB), (const pg8::bf16_t*)(F.ws + WS_WPA_T), MP, D, 512}; EpiMulAB E{F.ws};
        pg8::gemm_phase<EpiMulAB, PairOrder, true, true>(F.lds, g, S, E);
        if (BOTH(4)) GRID_BAR();
    }

    if (IN(5)) {
        sample_rows_p5(F);
        pg8::Gemm g{(const pg8::bf16_t*)(F.ws + WS_H), (const pg8::bf16_t*)(F.ws + WS_WO_T), MP, D, D}; pg8::StaticOrder S; S.init(MP, D, F.G, (int)blockIdx.x);
        EpiOut E{F.ws, F.out, IN_F(I_XP), IN_F(I_XS)};
        pg8::gemm_phase<EpiOut, pg8::StaticOrder, true, true>(F.lds, g, S, E);
        if (BOTH(5)) GRID_BAR();
    }

    if (IN(6)) {
        const int gw = F.vcu * NWAVES + F.wave, NGW = F.G * NWAVES, lane = F.lane;
        const float* fg = IN_F(I_FING);
        f32x4 gv[4];
#pragma unroll
        for (int j = 0; j < 4; ++j) gv[j] = *(const f32x4*)(fg + (lane + 64 * j) * 4);
        bool bar_dead = multi && (__hip_atomic_load((unsigned*)(F.ctl + CW_BAR) + XB_TMO, __ATOMIC_RELAXED, __HIP_MEMORY_SCOPE_AGENT) != 0u);
        for (int m0 = gw; m0 < MR; m0 += 4 * NGW) {
            f32x4 v[4][4]; float s[4];
#pragma unroll
            for (int q = 0; q < 4; ++q) { const int m = (m0 + q * NGW < MR) ? m0 + q * NGW : m0; const bf16* yr = (const bf16*)(F.ws + WS_T1) + (size_t)m * D;
                s[q] = (m < MP) ? ((lane < 16) ? ((const float*)(F.ws + WS_RSS))[(size_t)m * 16 + lane] : 0.f) : ((lane < 32) ? ((const float*)(F.ws + WS_RSSS))[(size_t)(m - MP) * 32 + lane] : 0.f);
#pragma unroll
                for (int j = 0; j < 4; ++j) { const u32x2 w = __builtin_nontemporal_load((const u32x2*)(yr + (lane + 64 * j) * 4)); v[q][j] = (f32x4){__uint_as_float(w.x << 16), __uint_as_float(w.x & 0xffff0000u), __uint_as_float(w.y << 16), __uint_as_float(w.y & 0xffff0000u)}; } }
#pragma unroll
            for (int q = 0; q < 4; ++q) { const int m = m0 + q * NGW; if (m >= MR) continue;
                float* yr = F.out + O_Y + (size_t)m * D;
                float rstd = 1.0f / sqrtf(wave_sum(s[q]) * (1.f / D) + EPS);
                if (bar_dead) rstd = __builtin_nanf("");
#pragma unroll
                for (int j = 0; j < 4; ++j) __builtin_nontemporal_store(v[q][j] * rstd * gv[j], (f32x4*)(yr + (lane + 64 * j) * 4)); }
        }
    }
#undef IN
#undef BOTH
#undef GRID_BAR
}

#ifndef MK_N_LAUNCHES
#define MK_N_LAUNCHES 7
#endif
extern "C" void kernel_launch(void* const* d_in, const int* in_sizes, int n_in, void* d_out, int out_size, void* d_ws, size_t ws_size, hipStream_t stream) {
    static int grid = 0;
    if (grid == 0) {
        if (n_in != 28 || (size_t)out_size != O_END || ws_size < WS_END) { fprintf(stderr, "kernel_launch: unexpected sizes n_in %d out %d (want %zu) ws %zu (want >= %zu)\n", n_in, out_size, (size_t)O_END, ws_size, (size_t)WS_END); grid = -1; return; }
        int dev = 0, cus = 0, per_cu = 0;
        if (hipGetDevice(&dev) != hipSuccess || hipDeviceGetAttribute(&cus, hipDeviceAttributeMultiprocessorCount, dev) != hipSuccess) { grid = -1; return; }
        if (hipFuncSetAttribute((const void*)nsa_fwd, hipFuncAttributeMaxDynamicSharedMemorySize, LDS_BYTES) != hipSuccess) { fprintf(stderr, "kernel_launch: hipFuncSetAttribute failed\n"); grid = -1; return; }
        if (hipOccupancyMaxActiveBlocksPerMultiprocessor(&per_cu, (const void*)nsa_fwd, NTHR, LDS_BYTES) != hipSuccess || per_cu < 1)
            fprintf(stderr, "kernel_launch: note: occupancy query reports %d workgroups per CU\n", per_cu);
        (void)hipGetLastError();
        grid = cus;
        if (grid < 128) { fprintf(stderr, "kernel_launch: device has %d CUs; built for >= 128\n", grid); grid = -1; return; }
    }
    if (grid < 0) return;
    if (hipMemsetAsync((char*)d_ws + WS_CTL, 0, CTL_ZERO_BYTES, stream) != hipSuccess) return;
    Args a{};
    for (int i = 0; i < 28; ++i) a.in[i] = d_in[i];
    a.out = (float*)d_out; a.ws = (unsigned char*)d_ws;
    if (MK_N_LAUNCHES == 1) { a.ph_lo = 0; a.ph_hi = N_PHASES; hipLaunchKernelGGL(nsa_fwd, dim3(grid), dim3(NTHR), LDS_BYTES, stream, a); }
    else for (int p = 0; p < N_PHASES; ++p) {
        a.ph_lo = p; a.ph_hi = p + 1; hipLaunchKernelGGL(nsa_fwd, dim3(grid), dim3(NTHR), LDS_BYTES, stream, a); }
}
```

```cpp
#define MK_N_LAUNCHES 1
#include <hip/hip_runtime.h>
#include <cstdio>
#include <cstdint>
#include <cmath>
namespace pg8 {
#define PG8_LAS __attribute__((address_space(3)))
typedef unsigned short bf16_t;
typedef short bf16x8 __attribute__((ext_vector_type(8)));
typedef float f32x4 __attribute__((ext_vector_type(4)));
typedef unsigned u32x4 __attribute__((ext_vector_type(4)));
constexpr int BM = 256, BK = 64, HALF = 128, HTB = HALF * BK * 2  , STAGE_BYTES = 8 * HTB, NXCD = 8, WGM = 8;

__host__ __device__ __forceinline__ int lds_byte(int r, int c) { const int st = (r >> 4) * 2 + (c >> 5), rr = r & 15, cc = c & 31, ob = rr * 64 + cc * 2; return st * 1024 + (ob ^ (((ob >> 9) & 1) << 5)); }
__host__ __device__ __forceinline__ void stage_rc(int b, int& R, int& C) { const int st = b / 1024, sb = b % 1024, swz = sb ^ (((sb >> 9) & 1) << 5); R = (st >> 1) * 16 + swz / 64; C = (st & 1) * 32 + (swz % 64) / 2; }
__host__ __device__ __forceinline__ int perm32(int rho) { const int n = rho >> 4, i = rho & 15; return 8 * (i >> 2) + 4 * n + (i & 3); }

struct Unit { int pm, pn; };
struct Gemm { const bf16_t* A; const bf16_t* Bt; int M, N, K; };

struct StaticOrder {
    int nM, nN, nwg, G, c;
    __host__ __device__ void init(int M, int N, int G_, int c_) { nM = M / BM; nN = N / BM; nwg = nM * nN; G = G_; c = c_; }
    __host__ __device__ bool next(int i, Unit& u) const {
        const long L = (long)i * G + c; if (L >= nwg) return false;
        int wgid = (int)L; { const int q = nwg / NXCD, r = nwg % NXCD, xcd = wgid % NXCD, off = wgid / NXCD; wgid = (xcd < r ? xcd * (q + 1) : r * (q + 1) + (xcd - r) * q) + off; }
        const int nig = WGM * nN, gid = wgid / nig, fm = gid * WGM, gsz = (nM - fm) < WGM ? (nM - fm) : WGM;
        u.pm = fm + ((wgid % nig) % gsz); u.pn = (wgid % nig) / gsz; return true;
    }
    __device__ __forceinline__ void a_ready(const Unit&) const {}
    __device__ __forceinline__ void done(const Unit&) const {}
};

__device__ __forceinline__ unsigned cvt_pk_bf16(float lo, float hi) { unsigned r; asm volatile("v_cvt_pk_bf16_f32 %0, %1, %2" : "=v"(r) : "v"(lo), "v"(hi)); return r; }
typedef float f32x2 __attribute__((ext_vector_type(2)));
template <class Epi, class Sched, bool ALIGN_EPI = false, bool SP2 = false>
__device__ __forceinline__ void gemm_phase(PG8_LAS unsigned char* lds, const Gemm g, const Sched& S, const Epi& E) {
    const int tid = threadIdx.x, wid = __builtin_amdgcn_readfirstlane(tid >> 6), lane = tid & 63, wr = wid >> 2, wc = wid & 3, fr = lane & 15, fq = lane >> 4;
    const int K = g.K, nt = K / BK;
    unsigned voffA[2], voffB[2];
#pragma unroll
    for (int i = 0; i < 2; ++i) { int R, C; stage_rc(tid * 16 + i * 8192, R, C); const int Rb = Epi::PERM ? ((R & ~31) + perm32(R & 31)) : R;
        voffA[i] = (unsigned)(R * K + C) * 2u; voffB[i] = (unsigned)(Rb * K + C) * 2u; }
    const size_t kstep = (size_t)(BK * 2);
    const size_t hstep = (size_t)HALF * K * 2;
    const size_t tstep = 2 * hstep;
    const unsigned ldsw = (unsigned)wid * 1024u;
    const int aoff = lds_byte(wr * 64 + fr, fq * 8), boff = lds_byte(wc * 32 + fr, fq * 8);
#define PG8_SA(b, h) (((b) * 2 + (h)) * HTB)
#define PG8_SB(b, h) ((4 + (b) * 2 + (h)) * HTB)
#define PG8_STAGE(bufoff, gbase, voff) do { _Pragma("unroll") for (int _i = 0; _i < 2; ++_i) \
        __builtin_amdgcn_global_load_lds((const unsigned*)((const char*)(gbase) + (voff)[_i]), (PG8_LAS unsigned*)(lds + (bufoff) + ldsw + _i * 8192), 16, 0, 0); } while (0)
#define PG8_LDA(dst, b, h) do { _Pragma("unroll") for (int m = 0; m < 4; ++m) _Pragma("unroll") for (int k = 0; k < 2; ++k) dst[m][k] = *(const PG8_LAS bf16x8*)(lds + PG8_SA(b, h) + aoff + m * 2048 + k * 1024); } while (0)
#define PG8_LDB(dst, b, h) do { _Pragma("unroll") for (int n = 0; n < 2; ++n) _Pragma("unroll") for (int k = 0; k < 2; ++k) dst[n][k] = *(const PG8_LAS bf16x8*)(lds + PG8_SB(b, h) + boff + n * 2048 + k * 1024); } while (0)
#define PG8_MMA(ai, bj, At, Bt) do { __builtin_amdgcn_s_setprio(1); _Pragma("unroll") for (int m = 0; m < 4; ++m) _Pragma("unroll") for (int n = 0; n < 2; ++n) _Pragma("unroll") for (int k = 0; k < 2; ++k) \
        acc[ai][bj][m][n] = __builtin_amdgcn_mfma_f32_16x16x32_bf16(Bt[n][k], At[m][k], acc[ai][bj][m][n], 0, 0, 0); __builtin_amdgcn_s_setprio(0); } while (0)
#define PG8_WAIT_V(n) asm volatile("s_waitcnt vmcnt(" #n ")" ::: "memory")
#define PG8_WAIT_L(n) asm volatile("s_waitcnt lgkmcnt(" #n ")" ::: "memory")
#define PG8_BAR __builtin_amdgcn_s_barrier()
#define PG8_SCHED __builtin_amdgcn_sched_barrier(0)
    Unit cur, nxt; int ui = 0;
    if (!S.next(0, cur)) return;
    f32x4 acc[2][2][4][2];
#pragma unroll
    for (int a = 0; a < 2; ++a)
#pragma unroll
        for (int b = 0; b < 2; ++b)
#pragma unroll
            for (int m = 0; m < 4; ++m)
#pragma unroll
                for (int n = 0; n < 2; ++n) acc[a][b][m][n] = (f32x4){0.f, 0.f, 0.f, 0.f};
    bf16x8 At[4][2], B0[2][2], B1[2][2];
    const char* cA = (const char*)g.A + (size_t)cur.pm * tstep; const char* cB = (const char*)g.Bt + (size_t)cur.pn * tstep;
    S.a_ready(cur);
    if constexpr (SP2) {
        PG8_STAGE(PG8_SB(0, 0), cB, voffB); PG8_STAGE(PG8_SB(0, 1), cB + hstep, voffB); PG8_STAGE(PG8_SA(0, 0), cA, voffA); PG8_STAGE(PG8_SA(0, 1), cA + hstep, voffA);
        if (wr == 1) PG8_BAR;
        PG8_WAIT_V(2); PG8_BAR;
        PG8_STAGE(PG8_SB(1, 0), cB + kstep, voffB); PG8_STAGE(PG8_SA(1, 0), cA + kstep, voffA); PG8_STAGE(PG8_SB(1, 1), cB + hstep + kstep, voffB);
        PG8_WAIT_V(6); PG8_BAR;
    } else {
        PG8_STAGE(PG8_SB(0, 0), cB, voffB); PG8_STAGE(PG8_SA(0, 0), cA, voffA); PG8_STAGE(PG8_SB(0, 1), cB + hstep, voffB); PG8_STAGE(PG8_SA(0, 1), cA + hstep, voffA);
        if (wr == 1) PG8_BAR;
        PG8_WAIT_V(4); PG8_BAR;
        PG8_STAGE(PG8_SB(1, 0), cB + kstep, voffB); PG8_STAGE(PG8_SA(1, 0), cA + kstep, voffA); PG8_STAGE(PG8_SB(1, 1), cB + hstep + kstep, voffB);
        PG8_WAIT_V(6); PG8_BAR;
    }
    for (;;) {
        const bool has_next = S.next(ui + 1, nxt);
        const char* nA = has_next ? (const char*)g.A + (size_t)nxt.pm * tstep : cA; const char* nB = has_next ? (const char*)g.Bt + (size_t)nxt.pn * tstep : cB;
        for (int t = 0; t < nt; t += 2) {
            const bool last = (t == nt - 2);
            const char* a1 = cA + (size_t)(t + 1) * kstep;
            const char* a2 = last ? nA : cA + (size_t)(t + 2) * kstep; const char* b2 = last ? nB : cB + (size_t)(t + 2) * kstep;
            const char* a3 = a2 + kstep; const char* b3 = b2 + kstep;
            if (last && has_next) S.a_ready(nxt);
            if constexpr (SP2) {
            PG8_LDB(B0, 0, 0); PG8_LDB(B1, 0, 1); PG8_SCHED; PG8_LDA(At, 0, 0); PG8_STAGE(PG8_SA(1, 1), a1 + hstep, voffA);
            PG8_WAIT_V(8); PG8_WAIT_L(0); PG8_BAR; PG8_MMA(0, 0, At, B0); PG8_MMA(0, 1, At, B1); PG8_BAR; PG8_SCHED;
            PG8_LDA(At, 0, 1); PG8_STAGE(PG8_SB(0, 0), b2, voffB); PG8_STAGE(PG8_SB(0, 1), b2 + hstep, voffB); PG8_STAGE(PG8_SA(0, 0), a2, voffA);
            PG8_WAIT_V(8); PG8_WAIT_L(0); PG8_BAR; PG8_MMA(1, 0, At, B0); PG8_MMA(1, 1, At, B1); PG8_BAR; PG8_SCHED;
            PG8_LDB(B0, 1, 0); PG8_LDB(B1, 1, 1); PG8_SCHED; PG8_LDA(At, 1, 0); PG8_STAGE(PG8_SA(0, 1), a2 + hstep, voffA);
            PG8_WAIT_V(8); PG8_WAIT_L(0); PG8_BAR; PG8_MMA(0, 0, At, B0); PG8_MMA(0, 1, At, B1); PG8_BAR; PG8_SCHED;
            PG8_LDA(At, 1, 1); PG8_STAGE(PG8_SB(1, 0), b3, voffB); PG8_STAGE(PG8_SB(1, 1), b3 + hstep, voffB); PG8_STAGE(PG8_SA(1, 0), a3, voffA);
            PG8_WAIT_V(8); PG8_WAIT_L(0); PG8_BAR; PG8_MMA(1, 0, At, B0); PG8_MMA(1, 1, At, B1); PG8_BAR; PG8_SCHED;
            } else {
            PG8_LDB(B0, 0, 0); PG8_SCHED; PG8_LDA(At, 0, 0); PG8_STAGE(PG8_SA(1, 1), a1 + hstep, voffA);
            PG8_WAIT_L(8); PG8_BAR; PG8_WAIT_L(0); PG8_MMA(0, 0, At, B0); PG8_BAR; PG8_SCHED;
            PG8_LDB(B1, 0, 1); PG8_STAGE(PG8_SB(0, 0), b2, voffB);
            PG8_BAR; PG8_WAIT_L(0); PG8_MMA(0, 1, At, B1); PG8_BAR;
            PG8_LDA(At, 0, 1); PG8_STAGE(PG8_SA(0, 0), a2, voffA);
            PG8_BAR; PG8_WAIT_L(0); PG8_MMA(1, 0, At, B0); PG8_BAR; PG8_SCHED;
            PG8_STAGE(PG8_SB(0, 1), b2 + hstep, voffB);
            PG8_WAIT_V(6); PG8_BAR; PG8_MMA(1, 1, At, B1); PG8_BAR;
            PG8_LDB(B0, 1, 0); PG8_SCHED; PG8_LDA(At, 1, 0); PG8_STAGE(PG8_SA(0, 1), a2 + hstep, voffA);
            PG8_WAIT_L(8); PG8_BAR; PG8_WAIT_L(0); PG8_MMA(0, 0, At, B0); PG8_BAR; PG8_SCHED;
            PG8_LDB(B1, 1, 1); PG8_STAGE(PG8_SB(1, 0), b3, voffB);
            PG8_BAR; PG8_WAIT_L(0); PG8_MMA(0, 1, At, B1); PG8_BAR;
            PG8_LDA(At, 1, 1); PG8_STAGE(PG8_SA(1, 0), a3, voffA);
            PG8_BAR; PG8_WAIT_L(0); PG8_MMA(1, 0, At, B0); PG8_BAR; PG8_SCHED;
            PG8_STAGE(PG8_SB(1, 1), b3 + hstep, voffB);
            PG8_WAIT_V(6); PG8_BAR; PG8_MMA(1, 1, At, B1); PG8_BAR;
            }
        }
        if constexpr (ALIGN_EPI) { if (wr == 0) PG8_BAR; }
        if constexpr (!Epi::AFTER_DRAIN) { E(acc, cur, wr, wc, fr, fq); S.done(cur); }
        if (!has_next) break;
#pragma unroll
        for (int a = 0; a < 2; ++a)
#pragma unroll
            for (int b = 0; b < 2; ++b)
#pragma unroll
                for (int m = 0; m < 4; ++m)
#pragma unroll
                    for (int n = 0; n < 2; ++n) acc[a][b][m][n] = (f32x4){0.f, 0.f, 0.f, 0.f};
        cur = nxt; cA = nA; cB = nB; ++ui;
        if constexpr (ALIGN_EPI) { if (wr == 1) PG8_BAR; }
    }
    PG8_WAIT_V(0);
    if constexpr (!ALIGN_EPI) { if (wr == 0) PG8_BAR; }
    PG8_BAR;
    if constexpr (Epi::AFTER_DRAIN) { E.fused(acc, cur, wr, wc, fr, fq, lds, wid, lane); S.done(cur); }
#undef PG8_SA
#undef PG8_SB
#undef PG8_STAGE
#undef PG8_LDA
#undef PG8_LDB
#undef PG8_MMA
#undef PG8_WAIT_V
#undef PG8_WAIT_L
#undef PG8_BAR
#undef PG8_SCHED
}
}

#define GAS __attribute__((address_space(1)))
#define LAS __attribute__((address_space(3)))
typedef unsigned short bf16;
typedef short bf16x8 __attribute__((ext_vector_type(8)));
typedef short s16x4 __attribute__((ext_vector_type(4)));
typedef float f32x4 __attribute__((ext_vector_type(4)));
typedef float f32x16 __attribute__((ext_vector_type(16)));
typedef unsigned u32x4 __attribute__((ext_vector_type(4)));
typedef unsigned u32x2 __attribute__((ext_vector_type(2)));
typedef GAS unsigned gu32;

constexpr int NWAVES = 8, NTHR = 512;
constexpr int D = 1024, NB = 8, SEQ = 2048, DB = 32, DS = 4, PAST = 16384;
constexpr int MP = NB * SEQ, MS = DB * DS, MR = MP + MS, M = 16640;
constexpr int NPADW = 5632;
constexpr float EPS = 1e-6f;
constexpr float LOG2E = 1.4426950408889634f;
constexpr float QSCALE = 0.125f * LOG2E;

constexpr size_t O_Y = 0;
constexpr size_t SZ_PKV = (size_t)MP * 128, SZ_PW = (size_t)NB * 512 * 128, SZ_SKV = (size_t)MS * 128, SZ_SW = (size_t)DB * 512 * 128;
constexpr size_t O_PKC = (size_t)MR * D, O_PVC = O_PKC + SZ_PKV, O_PKS = O_PVC + SZ_PKV, O_PVS = O_PKS + SZ_PKV;
constexpr size_t O_PKW = O_PVS + SZ_PKV, O_PVW = O_PKW + SZ_PW, O_PCONV = O_PVW + SZ_PW;
constexpr size_t O_SKC = O_PCONV + (size_t)NB * 30 * 512, O_SVC = O_SKC + SZ_SKV, O_SKS = O_SVC + SZ_SKV, O_SVS = O_SKS + SZ_SKV;
constexpr size_t O_SKW = O_SVS + SZ_SKV, O_SVW = O_SKW + SZ_SW, O_SCONV = O_SVW + SZ_SW, O_END = O_SCONV + (size_t)DB * 30 * 512;

constexpr size_t MiB = 1u << 20;
constexpr size_t WS_CTL = 0, CTL_ZERO_BYTES = 128 * 1024;
constexpr size_t WS_WIN_T = 2 * MiB, WS_PW_T = 14 * MiB, WS_WPA_T = 15 * MiB, WS_WPB_T = 16 * MiB, WS_WO_T = 17 * MiB;
constexpr size_t WS_W1_T = 19 * MiB;
constexpr size_t WS_W2_T = WS_W1_T + 512 * 1024;
constexpr size_t WS_PEH = WS_W2_T + 16 * 1024;
constexpr size_t WS_KCP = 20 * MiB;
constexpr size_t WS_VCPT = WS_KCP + 256 * 1024;
constexpr size_t WS_KCS = 21 * MiB, WS_VCS = 37 * MiB;
constexpr size_t WS_XN = 64 * MiB, WS_QB = 97 * MiB, WS_KS = 114 * MiB, WS_KW = 119 * MiB, WS_VST = 124 * MiB, WS_VWT = 128 * MiB;
constexpr size_t WS_GA = 132 * MiB, WS_U = 149 * MiB, WS_GB = 166 * MiB, WS_MG = 183 * MiB, WS_GN = 248 * MiB, WS_APW = 251 * MiB, WS_CB = 268 * MiB;
constexpr size_t WS_OA = 285 * MiB, WS_H = 302 * MiB, WS_T1 = 335 * MiB, WS_RSS = 368 * MiB, WS_END = 530 * MiB;
constexpr int CW_BAR = 4096;
constexpr int CW_QATT = 16384;

constexpr int RING_BYTES = 131072, LDSCTL_OFF = RING_BYTES, MISC_OFF = LDSCTL_OFF + 320, LDS_BYTES = 147456;

typedef float f32x2_t __attribute__((ext_vector_type(2))); typedef __bf16 bf16x2_t __attribute__((ext_vector_type(2)));
__device__ __forceinline__ unsigned pk2(float lo, float hi) { f32x2_t v = {lo, hi}; bf16x2_t b = __builtin_convertvector(v, bf16x2_t); return __builtin_bit_cast(unsigned, b); }
__device__ __forceinline__ float bf2f(unsigned short v) { return __uint_as_float((unsigned)v << 16); }
__device__ __forceinline__ float fexp2(float x) { return __builtin_amdgcn_exp2f(x); }
__device__ __forceinline__ float frcp(float x) { return __builtin_amdgcn_rcpf(x); }
__device__ __forceinline__ float sigmoidf_(float x) { return frcp(1.f + fexp2(-x * LOG2E)); }
__device__ __forceinline__ float siluf_(float x) { return x * sigmoidf_(x); }
__device__ __forceinline__ float wave_sum(float v) {
#pragma unroll
    for (int o = 1; o < 64; o <<= 1) v += __shfl_xor(v, o);
    return v;
}
__device__ __forceinline__ int crow(int i, int hi) { return (i & 3) + 8 * (i >> 2) + 4 * hi; }
__device__ __forceinline__ f32x16 mfma32(bf16x8 a, bf16x8 b, f32x16 c) { return __builtin_amdgcn_mfma_f32_32x32x16_bf16(a, b, c, 0, 0, 0); }
__device__ __forceinline__ bf16x8 pack8(float a0, float a1, float a2, float a3, float a4, float a5, float a6, float a7) {
    u32x4 w; w.x = pk2(a0, a1); w.y = pk2(a2, a3); w.z = pk2(a4, a5); w.w = pk2(a6, a7); return __builtin_bit_cast(bf16x8, w);
}
__device__ __forceinline__ bf16x8 pack8v(f32x4 a, f32x4 b) { return pack8(a.x, a.y, a.z, a.w, b.x, b.y, b.z, b.w); }

#define XB_TMO      128
#define XB_XCNT(j)  (256  + 64 * (j))
#define XB_XSUB(j)  (1280 + 64 * (j))
#define XB_XGEN(j)  (2304 + 64 * (j))
#define XB_TOP      3328
#define XB_TOPGEN   3392
#define XCD_BAR_WORDS 3456
#define XB_SPIN_CAP (1u << 18)
__device__ __forceinline__ unsigned xb_ld(unsigned* p)              { return __hip_atomic_load(p, __ATOMIC_RELAXED, __HIP_MEMORY_SCOPE_AGENT); }
__device__ __forceinline__ unsigned xb_add(unsigned* p, unsigned v) { return __hip_atomic_fetch_add(p, v, __ATOMIC_RELAXED, __HIP_MEMORY_SCOPE_AGENT); }
__device__ __forceinline__ unsigned xb_xcc_id() { return (unsigned)__builtin_amdgcn_s_getreg((3 << 11) | 20) & 0xFu; }
#define XB_SPIN(cond, bar) do { unsigned _sp = 0; while (cond) { __builtin_amdgcn_s_sleep(1); \
    if ((++_sp & 255u) == 0u) { if (xb_ld(&(bar)[XB_TMO])) break; if (_sp > XB_SPIN_CAP) { atomicAdd(&(bar)[XB_TMO], 1u); break; } } } } while (0)
struct XcdBarrier { unsigned* bar; unsigned x; volatile LAS unsigned* st; };
__device__ __forceinline__ XcdBarrier xcd_barrier_post(unsigned* bar, volatile LAS unsigned* st) {
    XcdBarrier b; b.bar = bar; b.x = xb_xcc_id(); b.st = st;
    if (threadIdx.x == 0) (void)xb_add(&bar[XB_XCNT(b.x)], 1u);
    return b;
}
__device__ __forceinline__ void xcd_barrier_complete(unsigned* bar, unsigned x, unsigned& nloc, unsigned& nx) {
    const unsigned G = gridDim.x * gridDim.y * gridDim.z;
    unsigned sum, cnt, mine, sp = 0u;
    for (;;) {
        sum = 0u; cnt = 0u; mine = 0u;
#pragma unroll
        for (unsigned j = 0; j < 16; ++j) { const unsigned c = xb_ld(&bar[XB_XCNT(j)]); sum += c; cnt += (c > 0u) ? 1u : 0u; mine = (j == x) ? c : mine; }
        if (sum == G) break;
        __builtin_amdgcn_s_sleep(1);
        if ((++sp & 255u) == 0u) { if (xb_ld(&bar[XB_TMO])) break; if (sp > XB_SPIN_CAP) { atomicAdd(&bar[XB_TMO], 1u); break; } }
    }
    nloc = mine > 0u ? mine : 1u; nx = cnt > 0u ? cnt : 1u;
}
__device__ __forceinline__ void xcd_barrier(const XcdBarrier& b) {
    asm volatile("s_waitcnt vmcnt(0)" ::: "memory");
    __syncthreads();
    if (threadIdx.x == 0) {
        unsigned* bar = b.bar;
        __builtin_amdgcn_s_waitcnt(0);
        unsigned nloc = b.st[0], nx = b.st[1];
        if (nloc == 0u) { xcd_barrier_complete(bar, b.x, nloc, nx); b.st[0] = nloc; b.st[1] = nx; }
        const unsigned old = xb_add(&bar[XB_XSUB(b.x)], 1u);
        const unsigned gen = old / nloc;
        if (old + 1u == (gen + 1u) * nloc) {
            __builtin_amdgcn_fence(__ATOMIC_RELEASE, "agent");
            asm volatile("s_waitcnt vmcnt(0)" ::: "memory");
            const unsigned og = xb_add(&bar[XB_TOP], 1u);
            const unsigned tg = og / nx;
            if (og + 1u == (tg + 1u) * nx) xb_add(&bar[XB_TOPGEN], 1u);
            else XB_SPIN(xb_ld(&bar[XB_TOPGEN]) == tg, bar);
            __builtin_amdgcn_fence(__ATOMIC_ACQUIRE, "agent");
            xb_add(&bar[XB_XGEN(b.x)], 1u);
            asm volatile("s_waitcnt vmcnt(0)" ::: "memory");
        } else {
            XB_SPIN(xb_ld(&bar[XB_XGEN(b.x)]) == gen, bar);
            __builtin_amdgcn_fence(__ATOMIC_ACQUIRE, "agent");
            asm volatile("s_waitcnt vmcnt(0)" ::: "memory");
        }
    }
    __syncthreads();
}

struct Frame {
    LAS unsigned char* lds;
    volatile LAS unsigned* MISC;
    gu32* ctl;
    int tid, lane, wave, vcu, G;
    const float* in[28];
    float* out;
    unsigned char* ws;
};
#define IN_F(k) ((const float*)F.in[k])
enum { I_XP = 0, I_XS, I_CKC, I_CVC, I_CKS, I_CVS, I_CKW, I_CVW, I_SCONV, I_PT, I_LNG, I_WIN, I_PEK, I_W1K, I_W2K, I_PEV, I_W1V, I_W2V, I_DWK, I_DWB, I_CLNG, I_CLNB, I_PWW, I_PWB, I_WPA, I_WPB, I_WO, I_FING };

__device__ __forceinline__ int colmap_in(int n) {
    if (n < 1280) return n;
    if (n < 1792) return 1304 + (n - 1280);
    if (n < 2816) { const int t = (n - 1792) >> 8, w = (n - 1792) & 255; return (w < 128) ? (1816 + 128 * t + w) : (2328 + 128 * t + (w - 128)); }
    if (n < 3328) return 2840 + (n - 2816);
    if (n < 5376) return 3352 + (n - 3328);
    if (n < 5400) return 1280 + (n - 5376);
    return -1;
}

template <bool MAPPED>
__device__ __forceinline__ void p0_transpose_item(const float* W, int ldS, bf16* WT, int ldD, int k0, int n0, LAS float* scr, int lane) {
    int c = n0 + (lane & 31); if (MAPPED) c = colmap_in(c);
    float wv[32];
#pragma unroll
    for (int i = 0; i < 32; ++i) { const int kk = 2 * i + (lane >> 5); wv[i] = (c >= 0) ? W[(size_t)(k0 + kk) * ldS + c] : 0.f; }
#pragma unroll
    for (int i = 0; i < 32; ++i) { const int kk = 2 * i + (lane >> 5); scr[kk * 33 + (lane & 31)] = wv[i]; }
    asm volatile("s_waitcnt lgkmcnt(0)" ::: "memory");
    const int ch = lane & 7;
#pragma unroll
    for (int j = 0; j < 4; ++j) { const int n = (lane >> 3) + 8 * j; const LAS float* s = scr + (8 * ch) * 33 + n;
        u32x4 o; o.x = pk2(s[0 * 33], s[1 * 33]); o.y = pk2(s[2 * 33], s[3 * 33]); o.z = pk2(s[4 * 33], s[5 * 33]); o.w = pk2(s[6 * 33], s[7 * 33]);
        *(u32x4*)(WT + (size_t)(n0 + n) * ldD + k0 + 8 * ch) = o; }
    asm volatile("s_waitcnt lgkmcnt(0)" ::: "memory");
}

constexpr int CMP_BS = 128 * 144;
constexpr int CMP_AS_OFF = 2 * CMP_BS, CMP_AS = 8192;
__device__ __forceinline__ void compress_finalize(Frame& F, f32x16 (&acc)[4], int tz, int bb, int g, int ct, bool samp, int nblk, LAS unsigned char* hs, int r32, int h) {
    const bf16* W2T = (const bf16*)(F.ws + WS_W2_T); const float* PEH = (const float*)(F.ws + WS_PEH);
#pragma unroll
            for (int n = 0; n < 2; ++n) {
                const float pe = PEH[tz * 64 + 32 * n + r32];
                float sh[16];
#pragma unroll
                for (int a = 0; a < 4; ++a) {
                    sh[4 * a] = acc[n + 2][4 * a + 1]; sh[4 * a + 1] = acc[n + 2][4 * a + 2]; sh[4 * a + 2] = acc[n + 2][4 * a + 3];
                    const float nxt = (a < 3) ? acc[n + 2][(a < 3) ? 4 * a + 4 : 0] : 0.f;
                    const float snd = h ? acc[n + 2][4 * a] : nxt;
                    sh[4 * a + 3] = __shfl_xor(snd, 32);
                }
#pragma unroll
                for (int i = 0; i < 16; ++i) { const float hv = pe + acc[n][i] + sh[i]; const float sv = siluf_(hv);
                    *(LAS unsigned short*)(hs + crow(i, h) * 144 + (32 * n + r32) * 2) = (unsigned short)(pk2(sv, 0.f) & 0xffffu); }
            }
            asm volatile("s_waitcnt lgkmcnt(0)" ::: "memory");
            f32x16 o2[2]; o2[0] = (f32x16)(0.f); o2[1] = (f32x16)(0.f);
#pragma unroll
            for (int s = 0; s < 4; ++s) {
                const bf16x8 a = *(const LAS bf16x8*)(hs + r32 * 144 + s * 32 + h * 16);
#pragma unroll
                for (int dt = 0; dt < 2; ++dt) { const bf16x8 b = *(const bf16x8*)(W2T + ((size_t)tz * 64 + 32 * dt + r32) * 64 + 16 * s + 8 * h); o2[dt] = mfma32(a, b, o2[dt]); }
            }
#pragma unroll
            for (int dt = 0; dt < 2; ++dt)
#pragma unroll
                for (int i = 0; i < 16; ++i) {
                    const int row = crow(i, h), bi = 31 * ct + row, d = 32 * dt + r32;
                    if (row < 31 && bi < nblk) {
                        if (samp) __builtin_nontemporal_store(o2[dt][i], (float*)(F.ws + (tz ? WS_VCS : WS_KCS)) + ((size_t)bb * 1024 + bi) * 128 + g * 64 + d);
                        else if (tz == 0) ((bf16*)(F.ws + WS_KCP))[((size_t)(bb * 2 + g) * 128 + bi) * 64 + d] = (bf16)(pk2(o2[dt][i], 0.f) & 0xffffu);
                        else ((bf16*)(F.ws + WS_VCPT))[((size_t)(bb * 2 + g) * 64 + d) * 128 + bi] = (bf16)(pk2(o2[dt][i], 0.f) & 0xffffu);
                    }
                }
}

constexpr int CMP_NT_S = 2 * DB * 2 * 33, CMP_NT_P = 2 * NB * 2 * 5, CMP_NT = CMP_NT_S + CMP_NT_P, CMP_TAIL_CUS = (CMP_NT % 2048 + 7) / 8;
__device__ __forceinline__ void compress_jobs(Frame& F, const int jstart, const int jend) {
    const int lane = F.lane, wave = F.wave, r32 = lane & 31, h = lane >> 5, tid = F.tid, cu = F.vcu, ncu = F.G;
    const bf16* W1T = (const bf16*)(F.ws + WS_W1_T); const bf16* W2T = (const bf16*)(F.ws + WS_W2_T); const float* PEH = (const float*)(F.ws + WS_PEH);
    const int* pt = (const int*)F.in[I_PT];
    LAS unsigned char* lds = F.lds;
    constexpr int CMP_FULL = (CMP_NT / 2048) * 2048;
    static_assert(CMP_FULL <= CMP_NT_S && (CMP_NT_S / 2) % 8 == 0, "full jobs hold sample wave-tiles of a single tensor");
    const int q4 = lane >> 4, pc = lane & 15;
    LAS unsigned char* bdst = lds + (tid >> 2) * 144 + (tid & 3) * 32;
    LAS unsigned char* AS = lds + CMP_AS_OFF + wave * CMP_AS;
    constexpr int nblk = 1023;
    u32x4 breg[2]; f32x4 ar0[8], ar1[8], ar2[8];
    int tz = 0, bb = 0, g = 0, ct = 0, j0 = 0; const float* abase = nullptr; const bf16* bsrc = nullptr; unsigned rb[8];
#define CMP_SETUP(JOB) do { \
        const int wt_ = 8 * (JOB) + wave;                        \
        j0 = (cu * 5 + ((JOB) / ncu) * 3) & 15;                  \
        tz = (8 * (JOB)) / (CMP_NT_S / 2);                       \
        { const int r1 = wt_ % (CMP_NT_S / 2); bb = r1 / 66; const int r2 = r1 % 66; ct = r2 >> 1; g = r2 & 1; } \
        abase = IN_F(tz ? I_CVC : I_CKC) + g * 64 + 4 * pc; \
        _Pragma("unroll") for (int i = 0; i < 8; ++i) { int c = 31 * ct + 4 * i + q4; if (c > 1023) c = 1023; const int page = pt[bb * 128 + (c >> 3)]; rb[i] = (unsigned)((page * 128 + (c & 7) * 16) * 128); } \
        bsrc = W1T + ((size_t)tz * 128 + (tid >> 2)) * 1024 + (tid & 3) * 16; \
        _Pragma("unroll") for (int q = 0; q < 2; ++q) breg[q] = *(const u32x4*)(bsrc + (j0 & 15) * 64 + q * 8); \
        _Pragma("unroll") for (int i = 0; i < 8; ++i) ar0[i] = __builtin_nontemporal_load((const f32x4*)(abase + rb[i] + (j0 & 15) * 128)); \
        _Pragma("unroll") for (int i = 0; i < 8; ++i) ar1[i] = __builtin_nontemporal_load((const f32x4*)(abase + rb[i] + ((j0 + 1) & 15) * 128)); \
        _Pragma("unroll") for (int i = 0; i < 8; ++i) ar2[i] = __builtin_nontemporal_load((const f32x4*)(abase + rb[i] + ((j0 + 2) & 15) * 128)); \
    } while (0)
    const int jlim = (jend < CMP_FULL / 8) ? jend : CMP_FULL / 8;
    int job = jstart;
    if (job < jlim) CMP_SETUP(job);
    while (job < jlim) {
        f32x16 acc[4];
#pragma unroll
        for (int n = 0; n < 4; ++n) acc[n] = (f32x16)(0.f);
        __syncthreads();
#pragma unroll
        for (int q = 0; q < 2; ++q) *(LAS u32x4*)(bdst + q * 16) = breg[q];
#define CMP_SLICE(J, AR) do { \
            __syncthreads(); \
            const int st_ = ((J) & 1) * CMP_BS; \
            if ((J) + 1 < 16) { _Pragma("unroll") for (int q = 0; q < 2; ++q) breg[q] = *(const u32x4*)(bsrc + ((j0 + (J) + 1) & 15) * 64 + q * 8); } \
            _Pragma("unroll") for (int i = 0; i < 8; ++i) *(LAS f32x4*)(AS + (4 * i + q4) * 256 + ((pc ^ ((4 * i + q4) & 15)) * 16)) = AR[i]; \
            if ((J) + 3 < 16) { _Pragma("unroll") for (int i = 0; i < 8; ++i) AR[i] = __builtin_nontemporal_load((const f32x4*)(abase + rb[i] + ((j0 + (J) + 3) & 15) * 128)); } \
            const LAS unsigned char* bl = lds + st_ + r32 * 144 + h * 16; \
            _Pragma("unroll") for (int s = 0; s < 4; ++s) { const f32x4 x0 = *(const LAS f32x4*)(AS + r32 * 256 + (((4 * s + 2 * h) ^ (r32 & 15)) * 16)), x1 = *(const LAS f32x4*)(AS + r32 * 256 + (((4 * s + 2 * h + 1) ^ (r32 & 15)) * 16)); const bf16x8 af = pack8v(x0, x1); \
                _Pragma("unroll") for (int n = 0; n < 4; ++n) { const bf16x8 bf = *(const LAS bf16x8*)(bl + n * 32 * 144 + s * 32); acc[n] = mfma32(af, bf, acc[n]); } } \
            if ((J) + 1 < 16) { LAS unsigned char* bd2 = bdst + (((J) + 1) & 1) * CMP_BS; _Pragma("unroll") for (int q = 0; q < 2; ++q) *(LAS u32x4*)(bd2 + q * 16) = breg[q]; } \
        } while (0)
        for (int j = 0; j < 15; j += 3) { CMP_SLICE(j, ar0); CMP_SLICE(j + 1, ar1); CMP_SLICE(j + 2, ar2); }
        CMP_SLICE(15, ar0);
#undef CMP_SLICE
        const int ftz = tz, fbb = bb, fg = g, fct = ct;
        job += ncu;
        if (job < jlim) CMP_SETUP(job);
        compress_finalize(F, acc, ftz, fbb, fg, fct, true, nblk, AS, r32, h);
    }
#undef CMP_SETUP
    __syncthreads();
}
__device__ __forceinline__ void compress_tail(Frame& F) {
    const int lane = F.lane, wave = F.wave, r32 = lane & 31, h = lane >> 5, cu = F.vcu, ncu = F.G;
    const bf16* W1T = (const bf16*)(F.ws + WS_W1_T);
    const int* pt = (const int*)F.in[I_PT];
    LAS unsigned char* lds = F.lds;
    constexpr int CMP_FULL = (CMP_NT / 2048) * 2048;
    constexpr int nrem = CMP_NT - CMP_FULL;
    for (int base = cu; base < nrem; base += 2 * ncu) {
        const bool two = base + ncu < nrem;
        const int wpt = two ? 4 : 8, sub = two ? (wave >> 2) : 0, kp = two ? (wave & 3) : wave, nsl = 16 / wpt, sl0 = kp * nsl;
        const int wt = CMP_FULL + base + sub * ncu;
        const bool samp = wt < CMP_NT_S;
        int tz, bb, g, ct;
        if (samp) { tz = wt / (CMP_NT_S / 2); const int r1 = wt % (CMP_NT_S / 2); bb = r1 / 66; const int r2 = r1 % 66; ct = r2 >> 1; g = r2 & 1; }
        else { const int w2 = wt - CMP_NT_S; tz = w2 / (CMP_NT_P / 2); const int r1 = w2 % (CMP_NT_P / 2); bb = r1 / 10; const int r2 = r1 % 10; ct = r2 >> 1; g = r2 & 1; }
        const int nchunk = samp ? 1024 : 128, nblk = samp ? 1023 : 127;
        int c = 31 * ct + r32; if (c > nchunk - 1) c = nchunk - 1;
        const float* arow;
        if (samp) { const int page = pt[bb * 128 + (c >> 3)]; arow = IN_F(tz ? I_CVC : I_CKC) + ((size_t)page * 128 + (c & 7) * 16) * 128 + g * 64 + 8 * h; }
        else arow = F.out + (tz ? O_PVC : O_PKC) + ((size_t)bb * SEQ + c * 16) * 128 + g * 64 + 8 * h;
        f32x16 acc[4];
#pragma unroll
        for (int n = 0; n < 4; ++n) acc[n] = (f32x16)(0.f);
        f32x4 arA[8], arB[8];
#define CMP_TLOAD(AR, SL) do { _Pragma("unroll") for (int s = 0; s < 4; ++s) { AR[2 * s] = *(const f32x4*)(arow + (SL) * 128 + 16 * s); AR[2 * s + 1] = *(const f32x4*)(arow + (SL) * 128 + 16 * s + 4); } } while (0)
#define CMP_TMMA(AR, SL) do { const bf16* bp = W1T + ((size_t)tz * 128 + r32) * 1024 + (SL) * 64 + 8 * h; \
            bf16x8 bfr[4][4];                                  \
            _Pragma("unroll") for (int s = 0; s < 4; ++s) _Pragma("unroll") for (int n = 0; n < 4; ++n) bfr[s][n] = *(const bf16x8*)(bp + (size_t)n * 32 * 1024 + 16 * s); \
            _Pragma("unroll") for (int s = 0; s < 4; ++s) { const bf16x8 af = pack8v(AR[2 * s], AR[2 * s + 1]); \
                _Pragma("unroll") for (int n = 0; n < 4; ++n) acc[n] = mfma32(af, bfr[s][n], acc[n]); } } while (0)
        CMP_TLOAD(arA, sl0); CMP_TLOAD(arB, sl0 + 1);
#pragma unroll 1
        for (int jj = 0; jj < nsl; jj += 2) {
            CMP_TMMA(arA, sl0 + jj);     if (jj + 2 < nsl) CMP_TLOAD(arA, sl0 + jj + 2);
            CMP_TMMA(arB, sl0 + jj + 1); if (jj + 3 < nsl) CMP_TLOAD(arB, sl0 + jj + 3);
        }
#undef CMP_TLOAD
#undef CMP_TMMA
        LAS float* R = (LAS float*)lds;
        __syncthreads();
#pragma unroll
        for (int n = 0; n < 4; ++n)
#pragma unroll
            for (int i = 0; i < 16; ++i) (R + wave * 4096 + lane)[(n * 16 + i) * 64] = acc[n][i];
        __syncthreads();
        if (kp == 0) {
#pragma unroll 1
            for (int w = 1; w < wpt; ++w) { const LAS float* Rw = R + (wave + w) * 4096 + lane;
#pragma unroll
                for (int n = 0; n < 4; ++n)
#pragma unroll
                    for (int i = 0; i < 16; ++i) acc[n][i] += Rw[(n * 16 + i) * 64]; }
        }
        __syncthreads();
        if (kp == 0) compress_finalize(F, acc, tz, bb, g, ct, samp, nblk, lds + wave * 16384, r32, h);
    }
    __syncthreads();
}

__device__ __forceinline__ void p0_prologue(Frame& F, const int part, const int cu, const int ncu) {
    const int gw = cu * NWAVES + F.wave, NGW = ncu * NWAVES, lane = F.lane;
    {
        LAS float* scr = (LAS float*)(F.lds + F.wave * 8704);
        constexpr int I_IN = 16 * (NPADW / 32), I_PW = 8 * 16, I_PA = 8 * 32, I_OO = 16 * 32, I_W1 = 16 * 2, I_W2 = 2;
        constexpr int NITEMS = I_IN + I_PW + 2 * I_PA + I_OO + 4 * I_W1 + 2 * I_W2;
        constexpr int I_B = I_IN + I_PW + 4 * I_W1 + 2 * I_W2;
        for (int it = (part == 0 ? 0 : part == 1 ? I_IN : I_B) + gw; it < (part == 0 ? I_IN : part == 1 ? I_B : NITEMS); it += NGW) {
            int r = it;
            if (r < I_IN) { p0_transpose_item<true>(IN_F(I_WIN), 5400, (bf16*)(F.ws + WS_WIN_T), 1024, 64 * (r / (NPADW / 32)), 32 * (r % (NPADW / 32)), scr, lane); continue; } r -= I_IN;
            if (r < I_PW) { p0_transpose_item<false>(IN_F(I_PWW), 512, (bf16*)(F.ws + WS_PW_T), 512, 64 * (r / 16), 32 * (r % 16), scr, lane); continue; } r -= I_PW;
            if (r < 4 * I_W1) { const int tz = r / (2 * I_W1), rr = (r / I_W1) & 1, q = r % I_W1;
                p0_transpose_item<false>(IN_F(tz ? I_W1V : I_W1K) + (size_t)rr * 1024 * 64, 64, (bf16*)(F.ws + WS_W1_T) + ((size_t)tz * 128 + rr * 64) * 1024, 1024, 64 * (q / 2), 32 * (q % 2), scr, lane); continue; } r -= 4 * I_W1;
            if (r < 2 * I_W2) { const int tz = r / I_W2, q = r % I_W2;
              p0_transpose_item<false>(IN_F(tz ? I_W2V : I_W2K), 64, (bf16*)(F.ws + WS_W2_T) + (size_t)tz * 4096, 64, 0, 32 * q, scr, lane); continue; } r -= 2 * I_W2;
            if (r < I_PA) { p0_transpose_item<false>(IN_F(I_WPA), 1024, (bf16*)(F.ws + WS_WPA_T), 512, 64 * (r / 32), 32 * (r % 32), scr, lane); continue; } r -= I_PA;
            if (r < I_PA) { p0_transpose_item<false>(IN_F(I_WPB), 1024, (bf16*)(F.ws + WS_WPB_T), 512, 64 * (r / 32), 32 * (r % 32), scr, lane); continue; } r -= I_PA;
            if (r < I_OO) { p0_transpose_item<false>(IN_F(I_WO), 1024, (bf16*)(F.ws + WS_WO_T), 1024, 64 * (r / 32), 32 * (r % 32), scr, lane); continue; }
        }
    }
    if (part == 1) for (int it = NGW - 1 - gw; it < 128; it += NGW) {
        const int tz = it >> 6, hh = it & 63; const float* pe = IN_F(tz ? I_PEV : I_PEK); const float* w1 = IN_F(tz ? I_W1V : I_W1K);
        float s = 0.f;
        for (int i = 0; i < 32; ++i) { const int k = lane + 64 * i; s += pe[k] * w1[(size_t)k * 64 + hh]; }
        s = wave_sum(s);
        if (lane == 0) ((float*)(F.ws + WS_PEH))[it] = s;
    }
    if (!part) {
        const float* lg = IN_F(I_LNG);
        f32x4 gv[4];
#pragma unroll
        for (int j = 0; j < 4; ++j) gv[j] = *(const f32x4*)(lg + (lane + 64 * j) * 4);
        for (int m0 = gw; m0 < M; m0 += 4 * NGW) {
            f32x4 v[4][4]; float ss[4];
#pragma unroll
            for (int q = 0; q < 4; ++q) { const int m = m0 + q * NGW; ss[q] = 0.f;
                if (m < MR) { const float* xr = (m < MP) ? IN_F(I_XP) + (size_t)m * D : IN_F(I_XS) + (size_t)(m - MP) * D;
#pragma unroll
                    for (int j = 0; j < 4; ++j) v[q][j] = __builtin_nontemporal_load((const f32x4*)(xr + (lane + 64 * j) * 4)); }
                else {
#pragma unroll
                    for (int j = 0; j < 4; ++j) v[q][j] = (f32x4){0.f, 0.f, 0.f, 0.f}; } }
#pragma unroll
            for (int q = 0; q < 4; ++q) {
#pragma unroll
                for (int j = 0; j < 4; ++j) ss[q] += (v[q][j].x * v[q][j].x + v[q][j].y * v[q][j].y) + (v[q][j].z * v[q][j].z + v[q][j].w * v[q][j].w); }
#pragma unroll
            for (int q = 0; q < 4; ++q) { const int m = m0 + q * NGW; if (m >= M) continue;
                const float rstd = 1.0f / sqrtf(wave_sum(ss[q]) * (1.f / D) + EPS);
                u32x2* o8 = (u32x2*)(F.ws + WS_XN + (size_t)m * D * 2) + lane;
#pragma unroll
                for (int j = 0; j < 4; ++j) { const f32x4 y = v[q][j] * rstd * gv[j]; o8[64 * j] = (m < MR) ? (u32x2){pk2(y.x, y.y), pk2(y.z, y.w)} : (u32x2){0u, 0u}; } }
        }
    }
    if (part == 2) {
        const int gt = cu * NTHR + F.tid, NGT = ncu * NTHR;
        constexpr int W4 = 508 * 128 / 4, C4 = 26 * 512 / 4;
        for (int i0 = gt; i0 < 2 * DB * W4; i0 += 4 * NGT) { f32x4 v[4];
#pragma unroll
            for (int k = 0; k < 4; ++k) { const int i = i0 + k * NGT; if (i < 2 * DB * W4) { const int tz = i / (DB * W4), r = i % (DB * W4), b = r / W4, q = r % W4; v[k] = __builtin_nontemporal_load((const f32x4*)(IN_F(tz ? I_CVW : I_CKW) + ((size_t)b * 512 + 4) * 128) + q); } }
#pragma unroll
            for (int k = 0; k < 4; ++k) { const int i = i0 + k * NGT; if (i < 2 * DB * W4) { const int tz = i / (DB * W4), r = i % (DB * W4), b = r / W4, q = r % W4; __builtin_nontemporal_store(v[k], (f32x4*)(F.out + (tz ? O_SVW : O_SKW) + (size_t)b * 512 * 128) + q); } } }
        for (int i = gt; i < DB * C4; i += NGT) { const int b = i / C4, q = i % C4;
            ((f32x4*)(F.out + O_SCONV + (size_t)b * 30 * 512))[q] = ((const f32x4*)(IN_F(I_SCONV) + ((size_t)b * 30 + 4) * 512))[q]; }
    }
    if (part == 1) {
        const int gt = cu * NTHR + F.tid, NGT = ncu * NTHR;
        for (int i = gt; i < NB * 2 * 64; i += NGT) { ((bf16*)(F.ws + WS_KCP))[((size_t)(i >> 6) * 128 + 127) * 64 + (i & 63)] = 0; ((bf16*)(F.ws + WS_VCPT))[(size_t)i * 128 + 127] = 0; }
        for (int i = gt; i < DB * 128; i += NGT) { ((float*)(F.ws + WS_KCS))[((size_t)(i >> 7) * 1024 + 1023) * 128 + (i & 127)] = 0.f; ((float*)(F.ws + WS_VCS))[((size_t)(i >> 7) * 1024 + 1023) * 128 + (i & 127)] = 0.f; }
    }
}

struct EpiIn {
    static constexpr bool PERM = true, AFTER_DRAIN = false;
    unsigned char* ws; float* out;
    __device__ __forceinline__ void operator()(const pg8::f32x4 (&acc)[2][2][4][2], const pg8::Unit& u, int wr, int wc, int fr, int fq) const {
        const int pn = u.pn;
#pragma unroll
        for (int ai = 0; ai < 2; ++ai)
#pragma unroll
            for (int m = 0; m < 4; ++m) {
                const int r = u.pm * 256 + ai * 128 + wr * 64 + m * 16 + fr;
                const int cl = wc * 32 + 8 * fq;
                if (pn >= 7 && pn <= 10) {
                    const f32x4 a0 = acc[ai][0][m][0], a1 = acc[ai][0][m][1], g0 = acc[ai][1][m][0], g1 = acc[ai][1][m][1];
                    f32x4 u0, u1;
#pragma unroll
                    for (int e = 0; e < 4; ++e) { u0[e] = a0[e] * sigmoidf_(g0[e]); u1[e] = a1[e] * sigmoidf_(g1[e]); }
                    const int ch = 128 * (pn - 7) + cl;
                    *(u32x4*)((bf16*)(ws + WS_U) + (size_t)r * 512 + ch) = (u32x4){pk2(u0.x, u0.y), pk2(u0.z, u0.w), pk2(u1.x, u1.y), pk2(u1.z, u1.w)};
                    float* dst = nullptr;
                    if (r < MP) { const int t = r & (SEQ - 1); if (t >= SEQ - 30) dst = out + O_PCONV + ((size_t)(r >> 11) * 30 + (t - (SEQ - 30))) * 512 + ch; }
                    else if (r < MR) { const int sm = r - MP; dst = out + O_SCONV + ((size_t)(sm >> 2) * 30 + 26 + (sm & 3)) * 512 + ch; }
                    if (dst) { *(f32x4*)dst = u0; *(f32x4*)(dst + 4) = u1; }
                    continue;
                }
#pragma unroll
                for (int bj = 0; bj < 2; ++bj) {
                    const f32x4 v0 = acc[ai][bj][m][0], v1 = acc[ai][bj][m][1];
                    const int c = pn * 256 + bj * 128 + cl;
                    if (pn < 2) {
                        *(u32x4*)((bf16*)(ws + WS_QB) + (size_t)r * 512 + c) = (u32x4){pk2(v0.x * QSCALE, v0.y * QSCALE), pk2(v0.z * QSCALE, v0.w * QSCALE), pk2(v1.x * QSCALE, v1.y * QSCALE), pk2(v1.z * QSCALE, v1.w * QSCALE)};
                    } else if (pn < 5) {
                        const int set = pn - 2;
                        float* dst = nullptr;
                        if (r < MP) {
                            if (set < 2) dst = out + O_PKC + (size_t)(2 * set + bj) * SZ_PKV + (size_t)r * 128 + cl;
                            else { const int t = r & (SEQ - 1); if (t >= SEQ - 512) dst = out + O_PKW + (size_t)bj * SZ_PW + ((size_t)(r >> 11) * 512 + (t - (SEQ - 512))) * 128 + cl; }
                        } else if (r < MR) {
                            const int sm = r - MP;
                            if (set < 2) dst = out + O_SKC + (size_t)(2 * set + bj) * SZ_SKV + (size_t)sm * 128 + cl;
                            else dst = out + O_SKW + (size_t)bj * SZ_SW + ((size_t)(sm >> 2) * 512 + 508 + (sm & 3)) * 128 + cl;
                        }
                        if (dst) { *(f32x4*)dst = v0; *(f32x4*)(dst + 4) = v1; }
                        if (set >= 1) {
                            if (bj == 0) *(u32x4*)((bf16*)(ws + (set == 1 ? WS_KS : WS_KW)) + (size_t)r * 128 + cl) = (u32x4){pk2(v0.x, v0.y), pk2(v0.z, v0.w), pk2(v1.x, v1.y), pk2(v1.z, v1.w)};
                            else if (r < MP) {
                                bf16* vt = (bf16*)(ws + (set == 1 ? WS_VST : WS_VWT)) + ((size_t)(r >> 11) * 128 + cl) * SEQ + (r & (SEQ - 1));
#pragma unroll
                                for (int e = 0; e < 4; ++e) { vt[(size_t)e * SEQ] = (bf16)(pk2(v0[e], 0.f) & 0xffffu); vt[(size_t)(e + 4) * SEQ] = (bf16)(pk2(v1[e], 0.f) & 0xffffu); }
                            }
                        }
                    } else if (pn < 7 || pn == 11 || pn == 12) {
                        bf16* dstb = (pn < 7) ? (bf16*)(ws + WS_GA) + (size_t)r * 512 + (c - 1280) : (bf16*)(ws + WS_GB) + (size_t)r * 512 + (c - 2816);
                        *(u32x4*)dstb = (u32x4){pk2(siluf_(v0.x), siluf_(v0.y)), pk2(siluf_(v0.z), siluf_(v0.w)), pk2(siluf_(v1.x), siluf_(v1.y)), pk2(siluf_(v1.z), siluf_(v1.w))};
                    } else if (pn < 21) {
                        *(u32x4*)((bf16*)(ws + WS_MG) + (size_t)r * 2048 + (c - 3328)) = (u32x4){pk2(sigmoidf_(v0.x), sigmoidf_(v0.y)), pk2(sigmoidf_(v0.z), sigmoidf_(v0.w)), pk2(sigmoidf_(v1.x), sigmoidf_(v1.y)), pk2(sigmoidf_(v1.z), sigmoidf_(v1.w))};
                    } else {
                        if (bj == 0 && wc == 0) { float* dg = (float*)(ws + WS_GN) + (size_t)r * 32 + cl;
                            *(f32x4*)dg = (f32x4){sigmoidf_(v0.x), sigmoidf_(v0.y), sigmoidf_(v0.z), sigmoidf_(v0.w)}; *(f32x4*)(dg + 4) = (f32x4){sigmoidf_(v1.x), sigmoidf_(v1.y), sigmoidf_(v1.z), sigmoidf_(v1.w)}; }
                    }
                }
            }
    }
};

constexpr int CV_TILE = 0, CV_T = 65536, CV_STATS = CV_T + 65536;
__device__ __forceinline__ void conv_load(Frame& F, int u, u32x4 (&v)[8]) {
    const int tid = F.tid;
    const bool samp = u >= 512; const int bb = samp ? u - 512 : u >> 6, t0 = samp ? 0 : 32 * (u & 63);
    const bf16* U = (const bf16*)(F.ws + WS_U);
#pragma unroll
    for (int k = 0; k < 8; ++k) { const int it = tid + k * NTHR; const int i = it >> 6, c8 = (it & 63) * 8; v[k] = (u32x4){0u, 0u, 0u, 0u};
        if (it < 62 * 64) {
            if (samp) {
                if (i < 30) { const float* sp = IN_F(I_SCONV) + ((size_t)bb * 30 + i) * 512 + c8; const f32x4 a = *(const f32x4*)sp, b2 = *(const f32x4*)(sp + 4); v[k] = (u32x4){pk2(a.x, a.y), pk2(a.z, a.w), pk2(b2.x, b2.y), pk2(b2.z, b2.w)}; }
                else if (i < 34) v[k] = *(const u32x4*)(U + (size_t)(MP + bb * 4 + i - 30) * 512 + c8);
            } else { const int t = t0 - 30 + i; if (t >= 0) v[k] = *(const u32x4*)(U + ((size_t)bb * SEQ + t) * 512 + c8); } } }
}
__device__ __forceinline__ void conv_unit(Frame& F, int u, int un, u32x4 (&v)[8], const float (&kw)[31], float bias, float lg, float lb) {
    LAS unsigned short* tile = (LAS unsigned short*)(F.lds + CV_TILE);
    LAS float* T = (LAS float*)(F.lds + CV_T);
    LAS float* stats = (LAS float*)(F.lds + CV_STATS);
    const int tid = F.tid, lane = F.lane, wave = F.wave;
    const bool samp = u >= 512; const int bb = samp ? u - 512 : u >> 6, t0 = samp ? 0 : 32 * (u & 63), nt = samp ? 4 : 32;
    __syncthreads();
#pragma unroll
    for (int k = 0; k < 8; ++k) { const int it = tid + k * NTHR; if (it < 62 * 64) *(LAS u32x4*)(tile + (it >> 6) * 512 + (it & 63) * 8) = v[k]; }
    if (un >= 0) conv_load(F, un, v);
    __syncthreads();
    const int ch = tid;
    for (int hf = 0; hf < 2; ++hf) {
        if (samp && hf) break;
        float x[46];
#pragma unroll
        for (int i = 0; i < 46; ++i) x[i] = bf2f(tile[(16 * hf + i) * 512 + ch]);
        float cv[16];
#pragma unroll
        for (int t = 0; t < 16; ++t) cv[t] = bias;
#pragma unroll
        for (int i = 0; i < 46; ++i) {
#pragma unroll
            for (int t = 0; t < 16; ++t) { const int w = i - t; if (w >= 0 && w < 31) cv[t] += kw[w] * x[i]; } }
#pragma unroll
        for (int t = 0; t < 16; ++t) T[(16 * hf + t) * 512 + ch] = cv[t];
    }
    __syncthreads();
#pragma unroll
    for (int q = 0; q < 4; ++q) { const int t = wave * 4 + q; float s1 = 0.f, s2 = 0.f;
#pragma unroll
        for (int k = 0; k < 8; ++k) { const float v = T[t * 512 + lane + 64 * k]; s1 += v; s2 += v * v; }
        s1 = wave_sum(s1); s2 = wave_sum(s2);
        if (lane == 0) { const float mu = s1 * (1.f / 512.f), var = fmaxf(s2 * (1.f / 512.f) - mu * mu, 0.f); stats[t * 2] = mu; stats[t * 2 + 1] = 1.0f / sqrtf(var + EPS); } }
    __syncthreads();
#pragma unroll
    for (int t = 0; t < 32; ++t) if (t < nt) {
        const float y = (T[t * 512 + ch] - stats[t * 2]) * stats[t * 2 + 1] * lg + lb;
        tile[t * 512 + ch] = (unsigned short)(pk2(siluf_(y), 0.f) & 0xffffu);
    }
    __syncthreads();
    bf16* A = (bf16*)(F.ws + WS_APW);
    for (int it = tid; it < nt * 64; it += NTHR) { const int t = it >> 6, c8 = (it & 63) * 8;
        const size_t m = samp ? (size_t)(MP + bb * 4 + t) : (size_t)bb * SEQ + t0 + t;
        *(u32x4*)(A + m * 512 + c8) = *(const LAS u32x4*)(tile + t * 512 + c8); }
}

struct Soft { f32x16 o0, o1; float m, l; };
__device__ __forceinline__ void soft_init(Soft& s, float m0 = -1e30f) { s.o0 = (f32x16)(0.f); s.o1 = (f32x16)(0.f); s.m = m0; s.l = 0.f; }

constexpr int KT_PITCH = 144, VT_PITCH = 136, KT_BYTES = 64 * KT_PITCH, VT_BYTES = 64 * VT_PITCH, KV_STAGE = KT_BYTES + VT_BYTES;
__device__ __forceinline__ void attn_half_step(Soft& st, f32x16& p, const LAS unsigned char* Vt, int kbase, int kpos, int lo, int hi, bool en, int mm, int r32, int h) {
    if (mm == 2) {
#pragma unroll
        for (int i = 0; i < 16; ++i) { const int kp = kpos + crow(i, h); const bool ok = en && kp >= lo && kp <= hi; p[i] = ok ? p[i] : -INFINITY; }
    }
    float mx = fmaxf(p[0], p[1]);
#pragma unroll
    for (int i = 2; i < 16; ++i) mx = fmaxf(mx, p[i]);
    if (mm == 1) mx = en ? mx : -INFINITY;
    mx = fmaxf(mx, __shfl_xor(mx, 32));
    if (__any(mx > st.m + 16.f)) {
        const float mn = (mx > st.m + 16.f) ? mx : st.m, alpha = fexp2(st.m - mn);
        st.m = mn; st.l *= alpha; st.o0 *= alpha; st.o1 *= alpha;
    }
    if (__any(st.m != 0.f)) {
#pragma unroll
        for (int i = 0; i < 16; ++i) p[i] -= st.m;
    }
#pragma unroll
    for (int i = 0; i < 16; ++i) p[i] = fexp2(p[i]);
    f32x2_t s2 = {p[0], p[1]};
#pragma unroll
    for (int i = 1; i < 8; ++i) s2 += (f32x2_t){p[2 * i], p[2 * i + 1]};
    const float sum = s2.x + s2.y;
    const bool off = (mm == 1) && !en;
    st.l += off ? 0.f : sum;
#pragma unroll
    for (int s = 0; s < 2; ++s) {
        u32x4 w; w.x = pk2(p[8 * s], p[8 * s + 1]); w.y = pk2(p[8 * s + 2], p[8 * s + 3]); w.z = pk2(p[8 * s + 4], p[8 * s + 5]); w.w = pk2(p[8 * s + 6], p[8 * s + 7]);
        if (mm == 1) { w.x = off ? 0u : w.x; w.y = off ? 0u : w.y; w.z = off ? 0u : w.z; w.w = off ? 0u : w.w; }
        const bf16x8 pb = __builtin_bit_cast(bf16x8, w);
        const int ko = (kbase + 16 * s + 4 * h) * 2;
        { const s16x4 a = *(const LAS s16x4*)(Vt + r32 * VT_PITCH + ko), b = *(const LAS s16x4*)(Vt + r32 * VT_PITCH + ko + 16);
          st.o0 = mfma32((bf16x8){a[0], a[1], a[2], a[3], b[0], b[1], b[2], b[3]}, pb, st.o0); }
        { const s16x4 a = *(const LAS s16x4*)(Vt + (32 + r32) * VT_PITCH + ko), b = *(const LAS s16x4*)(Vt + (32 + r32) * VT_PITCH + ko + 16);
          st.o1 = mfma32((bf16x8){a[0], a[1], a[2], a[3], b[0], b[1], b[2], b[3]}, pb, st.o1); }
    }
}
__device__ __forceinline__ void attn_tile_lds(Soft& st, const bf16x8 (&qf)[4], const LAS unsigned char* Kt, const LAS unsigned char* Vt, int kpos0, int lo, int hi, bool en, int mm, int r32, int h) {
    f32x16 p0 = (f32x16)(0.f), p1 = (f32x16)(0.f);
#pragma unroll
    for (int s = 0; s < 4; ++s) { const bf16x8 kf = *(const LAS bf16x8*)(Kt + r32 * KT_PITCH + s * 32 + h * 16); p0 = mfma32(kf, qf[s], p0); }
#pragma unroll
    for (int s = 0; s < 4; ++s) { const bf16x8 kf = *(const LAS bf16x8*)(Kt + (32 + r32) * KT_PITCH + s * 32 + h * 16); p1 = mfma32(kf, qf[s], p1); }
    attn_half_step(st, p0, Vt, 0, kpos0, lo, hi, en, mm, r32, h);
    attn_half_step(st, p1, Vt, 32, kpos0 + 32, lo, hi, en, mm, r32, h);
}
struct KVRegs { u32x4 k, v; };
__device__ __forceinline__ void kv_load(KVRegs& r, const bf16* Kg, int ldk, const bf16* Vg, int ldv, int key0, int tid) {
    const int row = tid >> 3, ch = tid & 7;
    r.k = *(const u32x4*)(Kg + (size_t)(key0 + row) * ldk + ch * 8);
    r.v = *(const u32x4*)(Vg + (size_t)row * ldv + key0 + ch * 8);
}
__device__ __forceinline__ void kv_store(const KVRegs& r, LAS unsigned char* stage, int tid) {
    const int row = tid >> 3, ch = tid & 7;
    *(LAS u32x4*)(stage + row * KT_PITCH + ch * 16) = r.k;
    LAS u32x2* vd = (LAS u32x2*)(stage + KT_BYTES + row * VT_PITCH + ch * 16);
    vd[0] = (u32x2){r.v.x, r.v.y}; vd[1] = (u32x2){r.v.z, r.v.w};
}
template <class EnFn, class ModeFn>
__device__ __forceinline__ void attn_branch_lds(Soft& st, const bf16x8 (&qf)[4], LAS unsigned char* kv, const bf16* Kg, int ldk, const bf16* Vg, int ldv,
                                                int jlo, int jhi, unsigned tilemask, int lo, int hi, const EnFn& en, const ModeFn& mode, int tid, int r32, int h) {
    unsigned todo = tilemask & ((jhi >= 31 ? 0xffffffffu : ((1u << (jhi + 1)) - 1u))) & ~((1u << jlo) - 1u);
    if (!todo) return;
    KVRegs r; int j = __builtin_ctz(todo); todo &= todo - 1u; int buf = 0;
    kv_load(r, Kg, ldk, Vg, ldv, 64 * j, tid);
    __syncthreads();
    kv_store(r, kv, tid);
    for (;;) {
        __syncthreads();
        const int jn = todo ? __builtin_ctz(todo) : -1;
        if (jn >= 0) { todo &= todo - 1u; kv_load(r, Kg, ldk, Vg, ldv, 64 * jn, tid); }
        attn_tile_lds(st, qf, kv + buf * KV_STAGE, kv + buf * KV_STAGE + KT_BYTES, 64 * j, lo, hi, en(j), mode(j), r32, h);
        if (jn < 0) break;
        kv_store(r, kv + (buf ^ 1) * KV_STAGE, tid);
        buf ^= 1; j = jn;
    }
}
__device__ __forceinline__ void soft_finish(f32x16& a0, f32x16& a1, Soft& st, float gate) {
    const float l = st.l + __shfl_xor(st.l, 32);
    const float sc = gate / fmaxf(l, 1e-30f);
    a0 += st.o0 * sc; a1 += st.o1 * sc;
}

constexpr int PA_KV = 0, PA_PST = 2 * KV_STAGE, PA_SC = PA_PST + 128 * 64 * 4, PA_SEL = PA_SC + 32 * 64 * 4, PA_ANY = PA_SEL + 256;
__device__ __forceinline__ void attn_prompt_unit(Frame& F, int b, int g, int qb) {
    const int tid = F.tid, lane = F.lane, wave = F.wave, r32 = lane & 31, h = lane >> 5;
    const int hh = wave >> 1, qh = wave & 1, ql = 32 * qh + r32, q0 = 64 * qb, qpos = q0 + ql;
    const size_t mrow = (size_t)b * SEQ + qpos;
    LAS unsigned char* lds = F.lds;
    LAS unsigned char* kv = lds + PA_KV;
    LAS float* psT = (LAS float*)(lds + PA_PST);
    LAS float* sc = (LAS float*)(lds + PA_SC);
    LAS unsigned* sel = (LAS unsigned*)(lds + PA_SEL);
    LAS unsigned* anysel = (LAS unsigned*)(lds + PA_ANY);
    bf16x8 qf[4];
    { const bf16* qp = (const bf16*)(F.ws + WS_QB) + mrow * 512 + (g * 4 + hh) * 64 + 8 * h;
#pragma unroll
      for (int s = 0; s < 4; ++s) qf[s] = *(const bf16x8*)(qp + 16 * s); }
    const float* gn = (const float*)(F.ws + WS_GN) + mrow * 32 + g * 12 + hh * 3;
    float gc = gn[0], gs = gn[1], gw_ = gn[2];
    f32x16 a0 = (f32x16)(0.f), a1 = (f32x16)(0.f);
    if (tid < 64) sel[tid] = 0u;
    if (tid == 64) anysel[0] = 0u;
    const bf16* Kc = (const bf16*)(F.ws + WS_KCP) + (size_t)(b * 2 + g) * 128 * 64;
    const bf16* Vc = (const bf16*)(F.ws + WS_VCPT) + (size_t)(b * 2 + g) * 64 * 128;
    const int hic = (qpos - 31) >> 4;
    Soft st; soft_init(st, 0.f);
    auto en_all = [](int) { return true; };
    auto mode_full = [](int) { return 2; };
    const int nct = (q0 + 63 >= 31 + 16 * 64) ? 2 : 1;
    attn_branch_lds(st, qf, kv, Kc, 64, Vc, 128, 0, nct - 1, 3u, 0, hic, en_all, mode_full, tid, r32, h);
    const float lc = st.l + __shfl_xor(st.l, 32), mc = st.m, rlc = 1.0f / fmaxf(lc, 1e-30f);
    soft_finish(a0, a1, st, gc);
    if (qb <= 15) { if (tid < 64) sel[tid] = (2u << qb) - 1u; if (tid == 64) anysel[0] = (2u << qb) - 1u; }
    else {
    for (int t = 0; t < 2; ++t) {
        f32x16 p[2]; const bool have = t < nct;
        if (have) {
#pragma unroll
            for (int kh = 0; kh < 2; ++kh) { p[kh] = (f32x16)(0.f);
#pragma unroll
                for (int s = 0; s < 4; ++s) { const bf16x8 kf = *(const LAS bf16x8*)(kv + t * KV_STAGE + (32 * kh + r32) * KT_PITCH + s * 32 + h * 16); p[kh] = mfma32(kf, qf[s], p[kh]); } }
        }
        for (int turn = 0; turn < 4; ++turn) {
            if (turn == hh) {
#pragma unroll
                for (int kh = 0; kh < 2; ++kh)
#pragma unroll
                    for (int i = 0; i < 16; ++i) { const int bi = 64 * t + 32 * kh + crow(i, h);
                        const float pn = (have && bi <= hic) ? fexp2(p[kh][i] - mc) * rlc : 0.f;
                        LAS float* d = psT + bi * 64 + ql; if (turn == 0) *d = pn; else *d += pn; }
            }
            __syncthreads();
        }
    }
    for (int it = 0; it < 4; ++it) { const int q = tid & 63, j = (tid >> 6) + 8 * it; float s = 0.f;
#pragma unroll
        for (int i = 4 * j - 1; i <= 4 * j + 3; ++i) if (i >= 0 && i <= 126) s += psT[i * 64 + q];
        float v = (j == 0 || j == qb || j == qb - 1) ? 1e4f : s; if (j > qb) v = -1.0f;
        sc[j * 64 + q] = v; }
    __syncthreads();
    for (int it = 0; it < 4; ++it) { const int q = tid & 63, j = (tid >> 6) + 8 * it; const float v = sc[j * 64 + q]; int rank = 0;
#pragma unroll
        for (int j2 = 0; j2 < 32; ++j2) { const float w = sc[j2 * 64 + q]; rank += (w > v || (w == v && j2 < j)) ? 1 : 0; }
        if (rank < 16 && j <= qb) { atomicOr((unsigned*)&sel[q], 1u << j); atomicOr((unsigned*)anysel, 1u << j); } }
    }
    __syncthreads();
    const unsigned mysel = sel[ql], tmask = anysel[0];
    soft_init(st, 0.f);
    { const bf16* Ks = (const bf16*)(F.ws + WS_KS) + (size_t)b * SEQ * 128 + g * 64;
      const bf16* Vs = (const bf16*)(F.ws + WS_VST) + (size_t)(b * 2 + g) * 64 * SEQ;
      auto en_sel = [mysel](int j) { return ((mysel >> j) & 1u) != 0u; };
      auto mode_sel = [qb](int j) { return (j == qb) ? 2 : (qb <= 15 ? 0 : 1); };
      attn_branch_lds(st, qf, kv, Ks, 128, Vs, SEQ, 0, qb, tmask, -1, qpos, en_sel, mode_sel, tid, r32, h); }
    soft_finish(a0, a1, st, gs);
    soft_init(st, 0.f);
    { const bf16* Kw = (const bf16*)(F.ws + WS_KW) + (size_t)b * SEQ * 128 + g * 64;
      const bf16* Vw = (const bf16*)(F.ws + WS_VWT) + (size_t)(b * 2 + g) * 64 * SEQ;
      auto mode_win = [qb](int j) { return (j == qb || j == qb - 8) ? 2 : 0; };
      attn_branch_lds(st, qf, kv, Kw, 128, Vw, SEQ, (qb >= 8) ? qb - 8 : 0, qb, 0xffffffffu, qpos - 512, qpos, en_all, mode_win, tid, r32, h); }
    soft_finish(a0, a1, st, gw_);
    const bf16* ga = (const bf16*)(F.ws + WS_GA) + mrow * 512 + (g * 4 + hh) * 64;
    bf16* oa = (bf16*)(F.ws + WS_OA) + mrow * 512 + (g * 4 + hh) * 64;
#pragma unroll
    for (int dh = 0; dh < 2; ++dh)
#pragma unroll
        for (int a = 0; a < 4; ++a) { const int d = 32 * dh + 8 * a + 4 * h; const u32x2 gv = *(const u32x2*)(ga + d);
            const f32x16& o = dh ? a1 : a0;
            const float x0 = o[4 * a] * __uint_as_float(gv.x << 16), x1 = o[4 * a + 1] * __uint_as_float(gv.x & 0xffff0000u), x2 = o[4 * a + 2] * __uint_as_float(gv.y << 16), x3 = o[4 * a + 3] * __uint_as_float(gv.y & 0xffff0000u);
            *(u32x2*)(oa + d) = (u32x2){pk2(x0, x1), pk2(x2, x3)}; }
    __syncthreads();
}

__device__ __forceinline__ void attn_half_f32(Soft& st, const bf16x8 (&qf)[4], const float* kb, const float* vb, int nrows, int kpos0, int lo, int hi, bool en,
                                              LAS float* sdump, int kidx0, int r32, int h) {
    f32x16 p = (f32x16)(0.f);
    { const int kr = (r32 < nrows) ? r32 : nrows - 1; const float* kp = kb + (size_t)kr * 128 + 8 * h;
      f32x4 kq[8];
#pragma unroll
      for (int s = 0; s < 4; ++s) { kq[2 * s] = *(const f32x4*)(kp + 16 * s); kq[2 * s + 1] = *(const f32x4*)(kp + 16 * s + 4); }
#pragma unroll
      for (int s = 0; s < 4; ++s) p = mfma32(pack8v(kq[2 * s], kq[2 * s + 1]), qf[s], p); }
    float vv[2][2][8];
#pragma unroll
    for (int dh = 0; dh < 2; ++dh)
#pragma unroll
        for (int s = 0; s < 2; ++s)
#pragma unroll
            for (int e = 0; e < 8; ++e) { int kr = 16 * s + 8 * (e >> 2) + 4 * h + (e & 3); kr = (kr < nrows) ? kr : nrows - 1; vv[dh][s][e] = vb[(size_t)kr * 128 + 32 * dh + r32]; }
    float mx = -INFINITY;
#pragma unroll
    for (int i = 0; i < 16; ++i) { const int kp = kpos0 + crow(i, h); const bool ok = en && kp >= lo && kp <= hi; p[i] = ok ? p[i] : -INFINITY; mx = fmaxf(mx, p[i]); }
    if (kidx0 >= 0 && r32 < 16) {
#pragma unroll
        for (int i = 0; i < 16; ++i) sdump[(kidx0 + crow(i, h)) * 16 + r32] = p[i];
    }
    mx = fmaxf(mx, __shfl_xor(mx, 32));
    const float mn = fmaxf(st.m, mx), alpha = fexp2(st.m - mn); st.m = mn;
    float sum = 0.f;
#pragma unroll
    for (int i = 0; i < 16; ++i) { p[i] = fexp2(p[i] - mn); sum += p[i]; }
    st.l = st.l * alpha + sum; st.o0 *= alpha; st.o1 *= alpha;
#pragma unroll
    for (int s = 0; s < 2; ++s) {
        const bf16x8 pb = pack8(p[8 * s], p[8 * s + 1], p[8 * s + 2], p[8 * s + 3], p[8 * s + 4], p[8 * s + 5], p[8 * s + 6], p[8 * s + 7]);
        st.o0 = mfma32(pack8(vv[0][s][0], vv[0][s][1], vv[0][s][2], vv[0][s][3], vv[0][s][4], vv[0][s][5], vv[0][s][6], vv[0][s][7]), pb, st.o0);
        st.o1 = mfma32(pack8(vv[1][s][0], vv[1][s][1], vv[1][s][2], vv[1][s][3], vv[1][s][4], vv[1][s][5], vv[1][s][6], vv[1][s][7]), pb, st.o1);
    }
}
constexpr int SA_SS = 0;
constexpr int SA_WP = 65536;
constexpr int SA_WP_STRIDE = (64 * 16 + 32) * 4;
constexpr int SA_OUT = SA_WP + 8 * SA_WP_STRIDE;
constexpr int SA_ML = SA_OUT + 4096;
constexpr int SA_SCS = SA_ML + 128;
constexpr int SA_SEL = SA_SCS + 4 * 260 * 4;
constexpr int SA_LIST = SA_SEL + 4 * 260;
constexpr int SA_GT = SA_LIST + 296;
constexpr int SA_END = SA_GT + 192;
static_assert(SA_END <= RING_BYTES, "sample attention LDS map");
__device__ __forceinline__ void sample_combine(Frame& F, Soft& st, int br, bool first, bool want_ml, int r32, int h) {
    LAS unsigned char* lds = F.lds; const int wave = F.wave, tid = F.tid;
    LAS float* wp = (LAS float*)(lds + SA_WP + wave * SA_WP_STRIDE);
    const float ltot = st.l + __shfl_xor(st.l, 32);
    if (r32 < 16) {
#pragma unroll
        for (int i = 0; i < 16; ++i) { wp[crow(i, h) * 16 + r32] = st.o0[i]; wp[(32 + crow(i, h)) * 16 + r32] = st.o1[i]; }
        if (h == 0) { wp[1024 + r32] = st.m; wp[1040 + r32] = ltot; }
    }
    __syncthreads();
    LAS float* OUT = (LAS float*)(lds + SA_OUT); LAS float* ML = (LAS float*)(lds + SA_ML); const LAS float* GT = (const LAS float*)(lds + SA_GT);
    for (int e = tid; e < 1024; e += NTHR) { const int col = e & 15, d = e >> 4;
        float mm = -1e30f;
#pragma unroll
        for (int w = 0; w < 8; ++w) mm = fmaxf(mm, ((const LAS float*)(lds + SA_WP + w * SA_WP_STRIDE))[1024 + col]);
        float L = 0.f, O = 0.f;
#pragma unroll
        for (int w = 0; w < 8; ++w) { const LAS float* q = (const LAS float*)(lds + SA_WP + w * SA_WP_STRIDE); const float f = fexp2(q[1024 + col] - mm); L += q[1040 + col] * f; O += q[d * 16 + col] * f; }
        const float v = GT[col * 3 + br] * O / fmaxf(L, 1e-30f);
        if (first) OUT[col * 64 + d] = v; else OUT[col * 64 + d] += v;
        if (want_ml && d == 0) { ML[col * 2] = mm; ML[col * 2 + 1] = 1.0f / fmaxf(L, 1e-30f); }
    }
    __syncthreads();
}
__device__ __forceinline__ void attn_sample_unit(Frame& F, int b, int g) {
    const int tid = F.tid, lane = F.lane, wave = F.wave, r32 = lane & 31, h = lane >> 5;
    const int col = r32 & 15, qi = col >> 2, hh = col & 3, qpos = PAST + qi;
    const size_t mrow = (size_t)MP + b * 4 + qi;
    LAS unsigned char* lds = F.lds;
    LAS float* SS = (LAS float*)(lds + SA_SS); LAS float* ML = (LAS float*)(lds + SA_ML); LAS float* SCS = (LAS float*)(lds + SA_SCS);
    LAS unsigned char* SEL = lds + SA_SEL; LAS int* LIST = (LAS int*)(lds + SA_LIST); LAS float* GT = (LAS float*)(lds + SA_GT);
    bf16x8 qf[4];
    { const bf16* qp = (const bf16*)(F.ws + WS_QB) + mrow * 512 + (g * 4 + hh) * 64 + 8 * h;
#pragma unroll
      for (int s = 0; s < 4; ++s) qf[s] = *(const bf16x8*)(qp + 16 * s); }
    __syncthreads();
    if (tid < 48) { const int c = tid / 3, br = tid % 3; GT[tid] = ((const float*)(F.ws + WS_GN))[((size_t)MP + b * 4 + (c >> 2)) * 32 + g * 12 + (c & 3) * 3 + br];
    }
    __syncthreads();
    const int* pt = (const int*)F.in[I_PT] + b * 128;
    Soft st;
    soft_init(st);
    { const float* kc = (const float*)(F.ws + WS_KCS) + (size_t)b * 1024 * 128 + g * 64; const float* vc = (const float*)(F.ws + WS_VCS) + (size_t)b * 1024 * 128 + g * 64;
      for (int ht = wave; ht < 32; ht += 8)
          attn_half_f32(st, qf, kc + (size_t)ht * 32 * 128, vc + (size_t)ht * 32 * 128, 32, 32 * ht, 0, 1022, true, SS, 32 * ht, r32, h); }
    sample_combine(F, st, 0, true, true, r32, h);
    if (tid < 4) { SCS[tid * 260 + 256] = 1e4f; SEL[tid * 260 + 256] = 1; }
    for (int e = tid; e < 4 * 256; e += NTHR) { const int q = e >> 8, j = e & 255; float s = 0.f;
        for (int i = 4 * j - 1; i <= 4 * j + 3; ++i) if (i >= 0 && i <= 1022) {
#pragma unroll
            for (int x = 0; x < 4; ++x) { const int c = q * 4 + x; s += fexp2(SS[i * 16 + c] - ML[c * 2]) * ML[c * 2 + 1]; } }
        SCS[q * 260 + j] = (j == 0 || j >= 255) ? 1e4f : s; }
    __syncthreads();
    for (int e = tid; e < 4 * 256; e += NTHR) { const int q = e >> 8, j = e & 255; const float v = SCS[q * 260 + j]; int rank = 0;
        for (int j2 = 0; j2 < 257; ++j2) { const float w = SCS[q * 260 + j2]; rank += (w > v || (w == v && j2 < j)) ? 1 : 0; }
        SEL[q * 260 + j] = (rank < 16) ? 1 : 0; }
    __syncthreads();
    if (wave == 0) { int cnt = 0;
        for (int base = 0; base < 257; base += 64) { const int j = base + lane;
            const bool f = (j < 257) && ((SEL[j] | SEL[260 + j] | SEL[520 + j] | SEL[780 + j]) != 0);
            const unsigned long long mk = __ballot(f);
            if (f) LIST[1 + cnt + __popcll(mk & ((1ull << lane) - 1ull))] = j;
            cnt += __popcll(mk); }
        if (lane == 0) LIST[0] = cnt; }
    __syncthreads();
    const int nsel = LIST[0];
    soft_init(st);
    for (int idx = wave; idx < 2 * nsel; idx += 8) { const int j = LIST[1 + (idx >> 1)], kh = idx & 1; const bool en = SEL[qi * 260 + j] != 0;
        if (j < 256) { const size_t ro = ((size_t)pt[j >> 1] * 128 + (j & 1) * 64 + 32 * kh) * 128 + g * 64;
            attn_half_f32(st, qf, IN_F(I_CKS) + ro, IN_F(I_CVS) + ro, 32, 64 * j + 32 * kh, 0, qpos, en, SS, -1, r32, h); }
        else if (kh == 0) { const size_t ro = (size_t)(b * 4) * 128 + g * 64;
            attn_half_f32(st, qf, F.out + O_SKS + ro, F.out + O_SVS + ro, 4, PAST, 0, qpos, en, SS, -1, r32, h); } }
    sample_combine(F, st, 1, false, false, r32, h);
    soft_init(st);
    for (int idx = wave; idx < 17; idx += 8) {
        if (idx < 16) { const size_t ro = ((size_t)b * 512 + 32 * idx) * 128 + g * 64;
            attn_half_f32(st, qf, IN_F(I_CKW) + ro, IN_F(I_CVW) + ro, 32, PAST - 512 + 32 * idx, qpos - 512, qpos, true, SS, -1, r32, h); }
        else { const size_t ro = ((size_t)b * 512 + 508) * 128 + g * 64;
            attn_half_f32(st, qf, F.out + O_SKW + ro, F.out + O_SVW + ro, 4, PAST, qpos - 512, qpos, true, SS, -1, r32, h); } }
    sample_combine(F, st, 2, false, false, r32, h);
    { const LAS float* OUT = (const LAS float*)(lds + SA_OUT);
      for (int e = tid; e < 1024; e += NTHR) { const int c = e >> 6, d = e & 63; const size_t m = (size_t)MP + b * 4 + (c >> 2); const int cc = (g * 4 + (c & 3)) * 64 + d;
          ((bf16*)(F.ws + WS_OA))[m * 512 + cc] = (bf16)(pk2(OUT[c * 64 + d] * bf2f(((const bf16*)(F.ws + WS_GA))[m * 512 + cc]), 0.f) & 0xffffu);
      } }
    __syncthreads();
}

__device__ __forceinline__ void unpack8(const u32x4 w, float (&f)[8]) {
    f[0] = __uint_as_float(w.x << 16); f[1] = __uint_as_float(w.x & 0xffff0000u); f[2] = __uint_as_float(w.y << 16); f[3] = __uint_as_float(w.y & 0xffff0000u);
    f[4] = __uint_as_float(w.z << 16); f[5] = __uint_as_float(w.z & 0xffff0000u); f[6] = __uint_as_float(w.w << 16); f[7] = __uint_as_float(w.w & 0xffff0000u);
}
template <int MODE> struct EpiMul {
    static constexpr bool PERM = true, AFTER_DRAIN = false;
    unsigned char* ws; const float* bias;
    __device__ __forceinline__ void operator()(const pg8::f32x4 (&acc)[2][2][4][2], const pg8::Unit& u, int wr, int wc, int fr, int fq) const {
#pragma unroll
        for (int ai = 0; ai < 2; ++ai)
#pragma unroll
            for (int m = 0; m < 4; ++m) { const size_t r = (size_t)u.pm * 256 + ai * 128 + wr * 64 + m * 16 + fr;
#pragma unroll
                for (int bj = 0; bj < 2; ++bj) { const int c = u.pn * 256 + bj * 128 + wc * 32 + 8 * fq;
                    float v[8]; const pg8::f32x4 v0 = acc[ai][bj][m][0], v1 = acc[ai][bj][m][1];
                    v[0] = v0.x; v[1] = v0.y; v[2] = v0.z; v[3] = v0.w; v[4] = v1.x; v[5] = v1.y; v[6] = v1.z; v[7] = v1.w;
                    float gt[8];
                    if (MODE == 0) { unpack8(*(const u32x4*)((const bf16*)(ws + WS_GB) + r * 512 + c), gt); const f32x4 b0 = *(const f32x4*)(bias + c), b1 = *(const f32x4*)(bias + c + 4);
                        v[0] += b0.x; v[1] += b0.y; v[2] += b0.z; v[3] += b0.w; v[4] += b1.x; v[5] += b1.y; v[6] += b1.z; v[7] += b1.w; }
                    else unpack8(*(const u32x4*)((const bf16*)(ws + WS_MG) + r * 2048 + (MODE == 2 ? 1024 : 0) + c), gt);
#pragma unroll
                    for (int e = 0; e < 8; ++e) v[e] *= gt[e];
                    bf16* dst = (MODE == 0) ? (bf16*)(ws + WS_CB) + r * 512 + c : (MODE == 1) ? (bf16*)(ws + WS_T1) + r * 1024 + c : (bf16*)(ws + WS_H) + r * 1024 + c;
                    if (MODE == 2) { float t[8]; unpack8(*(const u32x4*)((const bf16*)(ws + WS_T1) + r * 1024 + c), t);
#pragma unroll
                        for (int e = 0; e < 8; ++e) v[e] += t[e]; }
                    *(u32x4*)dst = (u32x4){pk2(v[0], v[1]), pk2(v[2], v[3]), pk2(v[4], v[5]), pk2(v[6], v[7])}; } }
    }
};
struct PairOrder {
    pg8::StaticOrder S;
    __device__ __forceinline__ bool next(int i, pg8::Unit& u) const { pg8::Unit b; if (!S.next(i >> 1, b)) return false;
        if (i & 1) { u.pm = b.pm; u.pn = b.pn + 4; } else { u.pm = b.pm + 68; u.pn = b.pn; } return true; }
    __device__ __forceinline__ void a_ready(const pg8::Unit&) const {}
    __device__ __forceinline__ void done(const pg8::Unit&) const {}
};
struct EpiMulAB {
    static constexpr bool PERM = true, AFTER_DRAIN = false;
    unsigned char* ws;
    __device__ __forceinline__ void operator()(const pg8::f32x4 (&acc)[2][2][4][2], const pg8::Unit& u, int wr, int wc, int fr, int fq) const {
        if (u.pn >= 4) { asm volatile("s_waitcnt vmcnt(0)" ::: "memory");
            const pg8::Unit v{u.pm, u.pn - 4}; EpiMul<2>{ws, nullptr}(acc, v, wr, wc, fr, fq); }
        else { const pg8::Unit v{u.pm - 68, u.pn}; EpiMul<1>{ws, nullptr}(acc, v, wr, wc, fr, fq); }
    }
};
struct EpiOut {
    static constexpr bool PERM = true, AFTER_DRAIN = false;
    unsigned char* ws; float* out; const float* xp; const float* xs;
    __device__ __forceinline__ void operator()(const pg8::f32x4 (&acc)[2][2][4][2], const pg8::Unit& u, int wr, int wc, int fr, int fq) const {
#pragma unroll
        for (int ai = 0; ai < 2; ++ai)
#pragma unroll
            for (int m = 0; m < 4; ++m) { const int r = u.pm * 256 + ai * 128 + wr * 64 + m * 16 + fr; const bool ok = r < MR;
                const float* xr = (r < MP) ? xp + (size_t)r * D : xs + (size_t)(ok ? r - MP : 0) * D;
                float ss = 0.f;
#pragma unroll
                for (int bj = 0; bj < 2; ++bj) { const int c = u.pn * 256 + bj * 128 + wc * 32 + 8 * fq;
                    f32x4 o0 = acc[ai][bj][m][0], o1 = acc[ai][bj][m][1];
                    if (ok) { o0 += __builtin_nontemporal_load((const f32x4*)(xr + c)); o1 += __builtin_nontemporal_load((const f32x4*)(xr + c + 4));
                        *(u32x4*)((bf16*)(ws + WS_T1) + (size_t)r * D + c) = (u32x4){pk2(o0.x, o0.y), pk2(o0.z, o0.w), pk2(o1.x, o1.y), pk2(o1.z, o1.w)}; }
                    ss += (o0.x * o0.x + o0.y * o0.y) + (o0.z * o0.z + o0.w * o0.w) + (o1.x * o1.x + o1.y * o1.y) + (o1.z * o1.z + o1.w * o1.w); }
                ss += __shfl_xor(ss, 16); ss += __shfl_xor(ss, 32);
                if (fq == 0) ((float*)(ws + WS_RSS))[(size_t)r * 16 + u.pn * 4 + wc] = ss; }
    }
};

constexpr size_t WS_RSSS = WS_RSS + 1100 * 1024;
__device__ __forceinline__ f32x16 wave_tile_partial(const bf16* A, int lda, const bf16* Bt, int ldb, int k0, int ksteps, int r32, int h) {
    f32x16 acc = (f32x16)(0.f);
    const bf16* ap = A + (size_t)r32 * lda + k0 + 8 * h; const bf16* bp = Bt + (size_t)r32 * ldb + k0 + 8 * h;
#pragma unroll 8
    for (int s = 0; s < ksteps; ++s) { const bf16x8 a = *(const bf16x8*)(ap + 16 * s), b = *(const bf16x8*)(bp + 16 * s); acc = mfma32(a, b, acc); }
    return acc;
}
__device__ __forceinline__ void sample_rows_p4(Frame& F) {
    if (F.vcu >= 128) return;
    const int lane = F.lane, wave = F.wave, r32 = lane & 31, h = lane >> 5, tid = F.tid;
    const int rg = F.vcu >> 5, cg = F.vcu & 31, row0 = MP + 32 * rg, col0 = 32 * cg;
    LAS float* P = (LAS float*)F.lds;
    float ga[2], gb[2];
#pragma unroll
    for (int q = 0; q < 2; ++q) { const int e = tid + q * NTHR; const int i = e >> 6, ln = e & 63; const size_t row = row0 + crow(i, ln >> 5); const int col = col0 + (ln & 31);
        const bf16* mg = (const bf16*)(F.ws + WS_MG) + row * 2048 + col; ga[q] = bf2f(mg[0]); gb[q] = bf2f(mg[1024]); }
    const f32x16 a1 = wave_tile_partial((const bf16*)(F.ws + WS_OA) + (size_t)row0 * 512, 512, (const bf16*)(F.ws + WS_WPA_T) + (size_t)col0 * 512, 512, 64 * wave, 4, r32, h);
    const f32x16 a2 = wave_tile_partial((const bf16*)(F.ws + WS_CB) + (size_t)row0 * 512, 512, (const bf16*)(F.ws + WS_WPB_T) + (size_t)col0 * 512, 512, 64 * wave, 4, r32, h);
    __syncthreads();
#pragma unroll
    for (int i = 0; i < 16; ++i) { P[(wave * 2) * 1024 + i * 64 + lane] = a1[i]; P[(wave * 2 + 1) * 1024 + i * 64 + lane] = a2[i]; }
    __syncthreads();
#pragma unroll
    for (int q = 0; q < 2; ++q) { const int e = tid + q * NTHR; float s1 = 0.f, s2 = 0.f;
#pragma unroll
        for (int w = 0; w < 8; ++w) { s1 += P[(w * 2) * 1024 + e]; s2 += P[(w * 2 + 1) * 1024 + e]; }
        const int i = e >> 6, ln = e & 63; const size_t row = row0 + crow(i, ln >> 5); const int col = col0 + (ln & 31);
        ((bf16*)(F.ws + WS_H))[row * 1024 + col] = (bf16)(pk2(ga[q] * s1 + gb[q] * s2, 0.f) & 0xffffu); }
    __syncthreads();
}
__device__ __forceinline__ void sample_rows_p5(Frame& F) {
    if (F.vcu >= 128) return;
    const int lane = F.lane, wave = F.wave, r32 = lane & 31, h = lane >> 5, tid = F.tid;
    const int rg = F.vcu >> 5, cg = F.vcu & 31, row0 = MP + 32 * rg, col0 = 32 * cg;
    LAS float* P = (LAS float*)F.lds;
    float xr[2];
#pragma unroll
    for (int q = 0; q < 2; ++q) { const int e = tid + q * NTHR; const int i = e >> 6, ln = e & 63; xr[q] = IN_F(I_XS)[(size_t)(32 * rg + crow(i, ln >> 5)) * D + col0 + (ln & 31)]; }
    const f32x16 a1 = wave_tile_partial((const bf16*)(F.ws + WS_H) + (size_t)row0 * 1024, 1024, (const bf16*)(F.ws + WS_WO_T) + (size_t)col0 * 1024, 1024, 128 * wave, 8, r32, h);
    __syncthreads();
#pragma unroll
    for (int i = 0; i < 16; ++i) P[wave * 1024 + i * 64 + lane] = a1[i];
    __syncthreads();
#pragma unroll
    for (int q = 0; q < 2; ++q) { const int e = tid + q * NTHR; float s1 = 0.f;
#pragma unroll
        for (int w = 0; w < 8; ++w) s1 += P[w * 1024 + e];
        const int i = e >> 6, ln = e & 63; const int srow = 32 * rg + crow(i, ln >> 5), col = col0 + (ln & 31);
        const float o = xr[q] + s1;
        ((bf16*)(F.ws + WS_T1))[(size_t)(MP + srow) * D + col] = (bf16)(pk2(o, 0.f) & 0xffffu);
        float ss = o * o;
        ss += __shfl_xor(ss, 1); ss += __shfl_xor(ss, 2); ss += __shfl_xor(ss, 4); ss += __shfl_xor(ss, 8); ss += __shfl_xor(ss, 16);
        if ((ln & 31) == 0) ((float*)(F.ws + WS_RSSS))[srow * 32 + cg] = ss; }
    __syncthreads();
}

constexpr int N_PHASES = 7;
struct Args { const void* in[28]; float* out; unsigned char* ws; int ph_lo, ph_hi; };
__global__ void __launch_bounds__(NTHR, 2) nsa_fwd(Args args) {
    extern __shared__ __attribute__((aligned(16))) unsigned char lds_raw[];
    Frame F;
    F.lds = (LAS unsigned char*)lds_raw;
    F.MISC = (volatile LAS unsigned*)(F.lds + MISC_OFF);
    F.tid = threadIdx.x; F.lane = F.tid & 63; F.wave = __builtin_amdgcn_readfirstlane(F.tid >> 6);
    F.G = gridDim.x; { const int bx = blockIdx.x; F.vcu = (F.G % 8 == 0) ? (bx % 8) * (F.G / 8) + bx / 8 : bx; }
#pragma unroll
    for (int i = 0; i < 28; ++i) F.in[i] = (const float*)args.in[i];
    F.out = args.out; F.ws = args.ws; F.ctl = (gu32*)(args.ws + WS_CTL);
    for (int u = F.tid; u < (LDS_BYTES - LDSCTL_OFF) / 4; u += NTHR) ((LAS unsigned*)(F.lds + LDSCTL_OFF))[u] = 0u;
    __syncthreads();
    const int lo = args.ph_lo, hi = args.ph_hi;
    const bool multi = (hi - lo) > 1;
    XcdBarrier bar; bar.bar = (unsigned*)(F.ctl + CW_BAR); bar.x = 0; bar.st = nullptr;
    if (multi) bar = xcd_barrier_post((unsigned*)(F.ctl + CW_BAR), F.MISC + 8);
#define IN(k) (lo <= (k) && (k) < hi)
#define BOTH(k) (IN(k) && ((k) + 1) < hi)
#define GRID_BAR() xcd_barrier(bar)

    if (IN(0)) { p0_prologue(F, 0, F.vcu, F.G); if (BOTH(0)) GRID_BAR(); }

    if (IN(1)) {
        pg8::Gemm g{(const pg8::bf16_t*)(F.ws + WS_XN), (const pg8::bf16_t*)(F.ws + WS_WIN_T), M, NPADW, D}; pg8::StaticOrder S; S.init(M, NPADW, F.G, (int)blockIdx.x);
        EpiIn E{F.ws, F.out};
        pg8::gemm_phase<EpiIn, pg8::StaticOrder, true, true>(F.lds, g, S, E);
        { const int nlast = S.nwg % F.G;
          if (nlast == 0) p0_prologue(F, 1, F.vcu, F.G); else if ((int)blockIdx.x >= nlast) { __syncthreads(); p0_prologue(F, 1, (int)blockIdx.x - nlast, F.G - nlast); } }
        if (BOTH(1)) GRID_BAR();
    }

    if (IN(2)) {
        const int cls = F.vcu % 3;
        auto conv_all = [&]() __attribute__((always_inline)) {
            float kw[31];
#pragma unroll
            for (int w = 0; w < 31; ++w) kw[w] = IN_F(I_DWK)[w * 512 + F.tid];
            const float cbias = IN_F(I_DWB)[F.tid], clg = IN_F(I_CLNG)[F.tid], clb = IN_F(I_CLNB)[F.tid];
            u32x4 cvv[8];
            int u = F.G - 1 - F.vcu;
            if (u < 512 + DB) conv_load(F, u, cvv);
            while (u < 512 + DB) { const int un = u + F.G; const bool pre = un < 512;
                conv_unit(F, u, pre ? un : -1, cvv, kw, cbias, clg, clb);
                if (!pre && un < 512 + DB) conv_load(F, un, cvv);
                u = un; }
            __syncthreads();
        };
        if (cls == 0) conv_all();
        compress_jobs(F, F.vcu, F.vcu + 1);
        if (cls == 1) conv_all();
        compress_jobs(F, F.vcu + F.G, 0x7fffffff);
        if (cls == 2) conv_all();
        compress_tail(F);
        if (BOTH(2)) GRID_BAR();
    }

    if (IN(3)) {
        constexpr int NSAMP = 2 * DB;
        const bool samp_cu = (F.G >= 4 * NSAMP) ? ((F.vcu & 3) == 0 && (F.vcu >> 2) < NSAMP) : (F.vcu < NSAMP);
        const int samp_id = (F.G >= 4 * NSAMP) ? (F.vcu >> 2) : F.vcu;
        const int gemm_id = (F.G >= 4 * NSAMP) ? ((F.vcu >> 2) < NSAMP ? F.vcu - (F.vcu >> 2) - 1 : F.vcu - NSAMP) : F.vcu - NSAMP;
        if (samp_cu) { attn_sample_unit(F, samp_id >> 1, samp_id & 1); }
        else {
            pg8::Gemm g{(const pg8::bf16_t*)(F.ws + WS_APW), (const pg8::bf16_t*)(F.ws + WS_PW_T), M, 512, 512}; pg8::StaticOrder S; S.init(M, 512, F.G - NSAMP, gemm_id);
            EpiMul<0> E{F.ws, IN_F(I_PWB)};
            pg8::gemm_phase<EpiMul<0>, pg8::StaticOrder, true, true>(F.lds, g, S, E);
        }
        int item;
        for (;;) {
            __syncthreads();
            if (F.tid == 0) F.MISC[0] = __hip_atomic_fetch_add((unsigned*)(F.ctl + CW_QATT), 1u, __ATOMIC_RELAXED, __HIP_MEMORY_SCOPE_AGENT);
            __syncthreads();
            item = (int)F.MISC[0];
            if (item >= 512) break;
            attn_prompt_unit(F, (item & 15) >> 1, item & 1, 31 - (item >> 4));
        }
        while (item < 512 + 2 * F.G) {
            p0_prologue(F, 2, item - 512, 2 * F.G);
            __syncthreads();
            if (F.tid == 0) F.MISC[0] = __hip_atomic_fetch_add((unsigned*)(F.ctl + CW_QATT), 1u, __ATOMIC_RELAXED, __HIP_MEMORY_SCOPE_AGENT);
            __syncthreads();
            item = (int)F.MISC[0];
        }
        if (BOTH(3)) GRID_BAR();
    }

    if (IN(4)) {
        sample_rows_p4(F);
        static_assert(WS_OA - WS_CB == (size_t)68 * 256 * 512 * 2 && WS_WPB_T - WS_WPA_T == (size_t)4 * 256 * 512 * 2, "stacked operand layout");
        PairOrder S; S.S.init(MP, D, F.G, (int)blockIdx.x);
        pg8::Gemm g{(const pg8::bf16_t*)(F.ws + WS_CB), (const pg8::bf16_t*)(F.ws + WS_WPA_T), MP, D, 512}; EpiMulAB E{F.ws};
        pg8::gemm_phase<EpiMulAB, PairOrder, true, true>(F.lds, g, S, E);
        if (BOTH(4)) GRID_BAR();
    }

    if (IN(5)) {
        sample_rows_p5(F);
        pg8::Gemm g{(const pg8::bf16_t*)(F.ws + WS_H), (const pg8::bf16_t*)(F.ws + WS_WO_T), MP, D, D}; pg8::StaticOrder S; S.init(MP, D, F.G, (int)blockIdx.x);
        EpiOut E{F.ws, F.out, IN_F(I_XP), IN_F(I_XS)};
        pg8::gemm_phase<EpiOut, pg8::StaticOrder, true, true>(F.lds, g, S, E);
        if (BOTH(5)) GRID_BAR();
    }

    if (IN(6)) {
        const int gw = F.vcu * NWAVES + F.wave, NGW = F.G * NWAVES, lane = F.lane;
        const float* fg = IN_F(I_FING);
        f32x4 gv[4];
#pragma unroll
        for (int j = 0; j < 4; ++j) gv[j] = *(const f32x4*)(fg + (lane + 64 * j) * 4);
        bool bar_dead = multi && (__hip_atomic_load((unsigned*)(F.ctl + CW_BAR) + XB_TMO, __ATOMIC_RELAXED, __HIP_MEMORY_SCOPE_AGENT) != 0u);
        for (int m0 = gw; m0 < MR; m0 += 4 * NGW) {
            f32x4 v[4][4]; float s[4];
#pragma unroll
            for (int q = 0; q < 4; ++q) { const int m = (m0 + q * NGW < MR) ? m0 + q * NGW : m0; const bf16* yr = (const bf16*)(F.ws + WS_T1) + (size_t)m * D;
                s[q] = (m < MP) ? ((lane < 16) ? ((const float*)(F.ws + WS_RSS))[(size_t)m * 16 + lane] : 0.f) : ((lane < 32) ? ((const float*)(F.ws + WS_RSSS))[(size_t)(m - MP) * 32 + lane] : 0.f);
#pragma unroll
                for (int j = 0; j < 4; ++j) { const u32x2 w = __builtin_nontemporal_load((const u32x2*)(yr + (lane + 64 * j) * 4)); v[q][j] = (f32x4){__uint_as_float(w.x << 16), __uint_as_float(w.x & 0xffff0000u), __uint_as_float(w.y << 16), __uint_as_float(w.y & 0xffff0000u)}; } }
#pragma unroll
            for (int q = 0; q < 4; ++q) { const int m = m0 + q * NGW; if (m >= MR) continue;
                float* yr = F.out + O_Y + (size_t)m * D;
                float rstd = 1.0f / sqrtf(wave_sum(s[q]) * (1.f / D) + EPS);
                if (bar_dead) rstd = __builtin_nanf("");
#pragma unroll
                for (int j = 0; j < 4; ++j) __builtin_nontemporal_store(v[q][j] * rstd * gv[j], (f32x4*)(yr + (lane + 64 * j) * 4)); }
        }
    }
#undef IN
#undef BOTH
#undef GRID_BAR
}

#ifndef MK_N_LAUNCHES
#define MK_N_LAUNCHES 7
#endif
extern "C" void kernel_launch(void* const* d_in, const int* in_sizes, int n_in, void* d_out, int out_size, void* d_ws, size_t ws_size, hipStream_t stream) {
    static int grid = 0;
    if (grid == 0) {
        if (n_in != 28 || (size_t)out_size != O_END || ws_size < WS_END) { fprintf(stderr, "kernel_launch: unexpected sizes n_in %d out %d (want %zu) ws %zu (want >= %zu)\n", n_in, out_size, (size_t)O_END, ws_size, (size_t)WS_END); grid = -1; return; }
        int dev = 0, cus = 0, per_cu = 0;
        if (hipGetDevice(&dev) != hipSuccess || hipDeviceGetAttribute(&cus, hipDeviceAttributeMultiprocessorCount, dev) != hipSuccess) { grid = -1; return; }
        if (hipFuncSetAttribute((const void*)nsa_fwd, hipFuncAttributeMaxDynamicSharedMemorySize, LDS_BYTES) != hipSuccess) { fprintf(stderr, "kernel_launch: hipFuncSetAttribute failed\n"); grid = -1; return; }
        if (hipOccupancyMaxActiveBlocksPerMultiprocessor(&per_cu, (const void*)nsa_fwd, NTHR, LDS_BYTES) != hipSuccess || per_cu < 1)
            fprintf(stderr, "kernel_launch: note: occupancy query reports %d workgroups per CU\n", per_cu);
        (void)hipGetLastError();
        grid = cus;
        if (grid < 128) { fprintf(stderr, "kernel_launch: device has %d CUs; built for >= 128\n", grid); grid = -1; return; }
    }
    if (grid < 0) return;
    if (hipMemsetAsync((char*)d_ws + WS_CTL, 0, CTL_ZERO_BYTES, stream) != hipSuccess) return;
    Args a{};
    for (int i = 0; i < 28; ++i) a.in[i] = d_in[i];
    a.out = (float*)d_out; a.ws = (unsigned char*)d_ws;
    if (MK_N_LAUNCHES == 1) { a.ph_lo = 0; a.ph_hi = N_PHASES; hipLaunchKernelGGL(nsa_fwd, dim3(grid), dim3(NTHR), LDS_BYTES, stream, a); }
    else for (int p = 0; p < N_PHASES; ++p) {
        a.ph_lo = p; a.ph_hi = p + 1; hipLaunchKernelGGL(nsa_fwd, dim3(grid), dim3(NTHR), LDS_BYTES, stream, a); }
}
```

```cpp
#define MK_N_LAUNCHES 1
#include <hip/hip_runtime.h>
#include <cstdio>
#include <cstdint>
#include <cmath>
namespace pg8 {
#define PG8_LAS __attribute__((address_space(3)))
typedef unsigned short bf16_t;
typedef short bf16x8 __attribute__((ext_vector_type(8)));
typedef float f32x4 __attribute__((ext_vector_type(4)));
typedef unsigned u32x4 __attribute__((ext_vector_type(4)));
constexpr int BM = 256, BK = 64, HALF = 128, HTB = HALF * BK * 2  , STAGE_BYTES = 8 * HTB, NXCD = 8, WGM = 8;

__host__ __device__ __forceinline__ int lds_byte(int r, int c) { const int st = (r >> 4) * 2 + (c >> 5), rr = r & 15, cc = c & 31, ob = rr * 64 + cc * 2; return st * 1024 + (ob ^ (((ob >> 9) & 1) << 5)); }
__host__ __device__ __forceinline__ void stage_rc(int b, int& R, int& C) { const int st = b / 1024, sb = b % 1024, swz = sb ^ (((sb >> 9) & 1) << 5); R = (st >> 1) * 16 + swz / 64; C = (st & 1) * 32 + (swz % 64) / 2; }
__host__ __device__ __forceinline__ int perm32(int rho) { const int n = rho >> 4, i = rho & 15; return 8 * (i >> 2) + 4 * n + (i & 3); }

struct Unit { int pm, pn; };
struct Gemm { const bf16_t* A; const bf16_t* Bt; int M, N, K; };

struct StaticOrder {
    int nM, nN, nwg, G, c;
    __host__ __device__ void init(int M, int N, int G_, int c_) { nM = M / BM; nN = N / BM; nwg = nM * nN; G = G_; c = c_; }
    __host__ __device__ bool next(int i, Unit& u) const {
        const long L = (long)i * G + c; if (L >= nwg) return false;
        int wgid = (int)L; { const int q = nwg / NXCD, r = nwg % NXCD, xcd = wgid % NXCD, off = wgid / NXCD; wgid = (xcd < r ? xcd * (q + 1) : r * (q + 1) + (xcd - r) * q) + off; }
        const int nig = WGM * nN, gid = wgid / nig, fm = gid * WGM, gsz = (nM - fm) < WGM ? (nM - fm) : WGM;
        u.pm = fm + ((wgid % nig) % gsz); u.pn = (wgid % nig) / gsz; return true;
    }
    __device__ __forceinline__ void a_ready(const Unit&) const {}
    __device__ __forceinline__ void done(const Unit&) const {}
};

__device__ __forceinline__ unsigned cvt_pk_bf16(float lo, float hi) { unsigned r; asm volatile("v_cvt_pk_bf16_f32 %0, %1, %2" : "=v"(r) : "v"(lo), "v"(hi)); return r; }
typedef float f32x2 __attribute__((ext_vector_type(2)));
template <class Epi, class Sched, bool ALIGN_EPI = false, bool SP2 = false>
__device__ __forceinline__ void gemm_phase(PG8_LAS unsigned char* lds, const Gemm g, const Sched& S, const Epi& E) {
    const int tid = threadIdx.x, wid = __builtin_amdgcn_readfirstlane(tid >> 6), lane = tid & 63, wr = wid >> 2, wc = wid & 3, fr = lane & 15, fq = lane >> 4;
    const int K = g.K, nt = K / BK;
    unsigned voffA[2], voffB[2];
#pragma unroll
    for (int i = 0; i < 2; ++i) { int R, C; stage_rc(tid * 16 + i * 8192, R, C); const int Rb = Epi::PERM ? ((R & ~31) + perm32(R & 31)) : R;
        voffA[i] = (unsigned)(R * K + C) * 2u; voffB[i] = (unsigned)(Rb * K + C) * 2u; }
    const size_t kstep = (size_t)(BK * 2);
    const size_t hstep = (size_t)HALF * K * 2;
    const size_t tstep = 2 * hstep;
    const unsigned ldsw = (unsigned)wid * 1024u;
    const int aoff = lds_byte(wr * 64 + fr, fq * 8), boff = lds_byte(wc * 32 + fr, fq * 8);
#define PG8_SA(b, h) (((b) * 2 + (h)) * HTB)
#define PG8_SB(b, h) ((4 + (b) * 2 + (h)) * HTB)
#define PG8_STAGE(bufoff, gbase, voff) do { _Pragma("unroll") for (int _i = 0; _i < 2; ++_i) \
        __builtin_amdgcn_global_load_lds((const unsigned*)((const char*)(gbase) + (voff)[_i]), (PG8_LAS unsigned*)(lds + (bufoff) + ldsw + _i * 8192), 16, 0, 0); } while (0)
#define PG8_LDA(dst, b, h) do { _Pragma("unroll") for (int m = 0; m < 4; ++m) _Pragma("unroll") for (int k = 0; k < 2; ++k) dst[m][k] = *(const PG8_LAS bf16x8*)(lds + PG8_SA(b, h) + aoff + m * 2048 + k * 1024); } while (0)
#define PG8_LDB(dst, b, h) do { _Pragma("unroll") for (int n = 0; n < 2; ++n) _Pragma("unroll") for (int k = 0; k < 2; ++k) dst[n][k] = *(const PG8_LAS bf16x8*)(lds + PG8_SB(b, h) + boff + n * 2048 + k * 1024); } while (0)
#define PG8_MMA(ai, bj, At, Bt) do { __builtin_amdgcn_s_setprio(1); _Pragma("unroll") for (int m = 0; m < 4; ++m) _Pragma("unroll") for (int n = 0; n < 2; ++n) _Pragma("unroll") for (int k = 0; k < 2; ++k) \
        acc[ai][bj][m][n] = __builtin_amdgcn_mfma_f32_16x16x32_bf16(Bt[n][k], At[m][k], acc[ai][bj][m][n], 0, 0, 0); __builtin_amdgcn_s_setprio(0); } while (0)
#define PG8_WAIT_V(n) asm volatile("s_waitcnt vmcnt(" #n ")" ::: "memory")
#define PG8_WAIT_L(n) asm volatile("s_waitcnt lgkmcnt(" #n ")" ::: "memory")
#define PG8_BAR __builtin_amdgcn_s_barrier()
#define PG8_SCHED __builtin_amdgcn_sched_barrier(0)
    Unit cur, nxt; int ui = 0;
    if (!S.next(0, cur)) return;
    f32x4 acc[2][2][4][2];
#pragma unroll
    for (int a = 0; a < 2; ++a)
#pragma unroll
        for (int b = 0; b < 2; ++b)
#pragma unroll
            for (int m = 0; m < 4; ++m)
#pragma unroll
                for (int n = 0; n < 2; ++n) acc[a][b][m][n] = (f32x4){0.f, 0.f, 0.f, 0.f};
    bf16x8 At[4][2], B0[2][2], B1[2][2];
    const char* cA = (const char*)g.A + (size_t)cur.pm * tstep; const char* cB = (const char*)g.Bt + (size_t)cur.pn * tstep;
    S.a_ready(cur);
    if constexpr (SP2) {
        PG8_STAGE(PG8_SB(0, 0), cB, voffB); PG8_STAGE(PG8_SB(0, 1), cB + hstep, voffB); PG8_STAGE(PG8_SA(0, 0), cA, voffA); PG8_STAGE(PG8_SA(0, 1), cA + hstep, voffA);
        if (wr == 1) PG8_BAR;
        PG8_WAIT_V(2); PG8_BAR;
        PG8_STAGE(PG8_SB(1, 0), cB + kstep, voffB); PG8_STAGE(PG8_SA(1, 0), cA + kstep, voffA); PG8_STAGE(PG8_SB(1, 1), cB + hstep + kstep, voffB);
        PG8_WAIT_V(6); PG8_BAR;
    } else {
        PG8_STAGE(PG8_SB(0, 0), cB, voffB); PG8_STAGE(PG8_SA(0, 0), cA, voffA); PG8_STAGE(PG8_SB(0, 1), cB + hstep, voffB); PG8_STAGE(PG8_SA(0, 1), cA + hstep, voffA);
        if (wr == 1) PG8_BAR;
        PG8_WAIT_V(4); PG8_BAR;
        PG8_STAGE(PG8_SB(1, 0), cB + kstep, voffB); PG8_STAGE(PG8_SA(1, 0), cA + kstep, voffA); PG8_STAGE(PG8_SB(1, 1), cB + hstep + kstep, voffB);
        PG8_WAIT_V(6); PG8_BAR;
    }
    for (;;) {
        const bool has_next = S.next(ui + 1, nxt);
        const char* nA = has_next ? (const char*)g.A + (size_t)nxt.pm * tstep : cA; const char* nB = has_next ? (const char*)g.Bt + (size_t)nxt.pn * tstep : cB;
        for (int t = 0; t < nt; t += 2) {
            const bool last = (t == nt - 2);
            const char* a1 = cA + (size_t)(t + 1) * kstep;
            const char* a2 = last ? nA : cA + (size_t)(t + 2) * kstep; const char* b2 = last ? nB : cB + (size_t)(t + 2) * kstep;
            const char* a3 = a2 + kstep; const char* b3 = b2 + kstep;
            if (last && has_next) S.a_ready(nxt);
            if constexpr (SP2) {
            PG8_LDB(B0, 0, 0); PG8_LDB(B1, 0, 1); PG8_SCHED; PG8_LDA(At, 0, 0); PG8_STAGE(PG8_SA(1, 1), a1 + hstep, voffA);
            PG8_WAIT_V(8); PG8_WAIT_L(0); PG8_BAR; PG8_MMA(0, 0, At, B0); PG8_MMA(0, 1, At, B1); PG8_BAR; PG8_SCHED;
            PG8_LDA(At, 0, 1); PG8_STAGE(PG8_SB(0, 0), b2, voffB); PG8_STAGE(PG8_SB(0, 1), b2 + hstep, voffB); PG8_STAGE(PG8_SA(0, 0), a2, voffA);
            PG8_WAIT_V(8); PG8_WAIT_L(0); PG8_BAR; PG8_MMA(1, 0, At, B0); PG8_MMA(1, 1, At, B1); PG8_BAR; PG8_SCHED;
            PG8_LDB(B0, 1, 0); PG8_LDB(B1, 1, 1); PG8_SCHED; PG8_LDA(At, 1, 0); PG8_STAGE(PG8_SA(0, 1), a2 + hstep, voffA);
            PG8_WAIT_V(8); PG8_WAIT_L(0); PG8_BAR; PG8_MMA(0, 0, At, B0); PG8_MMA(0, 1, At, B1); PG8_BAR; PG8_SCHED;
            PG8_LDA(At, 1, 1); PG8_STAGE(PG8_SB(1, 0), b3, voffB); PG8_STAGE(PG8_SB(1, 1), b3 + hstep, voffB); PG8_STAGE(PG8_SA(1, 0), a3, voffA);
            PG8_WAIT_V(8); PG8_WAIT_L(0); PG8_BAR; PG8_MMA(1, 0, At, B0); PG8_MMA(1, 1, At, B1); PG8_BAR; PG8_SCHED;
            } else {
            PG8_LDB(B0, 0, 0); PG8_SCHED; PG8_LDA(At, 0, 0); PG8_STAGE(PG8_SA(1, 1), a1 + hstep, voffA);
            PG8_WAIT_L(8); PG8_BAR; PG8_WAIT_L(0); PG8_MMA(0, 0, At, B0); PG8_BAR; PG8_SCHED;
            PG8_LDB(B1, 0, 1); PG8_STAGE(PG8_SB(0, 0), b2, voffB);
            PG8_BAR; PG8_WAIT_L(0); PG8_MMA(0, 1, At, B1); PG8_BAR;
            PG8_LDA(At, 0, 1); PG8_STAGE(PG8_SA(0, 0), a2, voffA);
            PG8_BAR; PG8_WAIT_L(0); PG8_MMA(1, 0, At, B0); PG8_BAR; PG8_SCHED;
            PG8_STAGE(PG8_SB(0, 1), b2 + hstep, voffB);
            PG8_WAIT_V(6); PG8_BAR; PG8_MMA(1, 1, At, B1); PG8_BAR;
            PG8_LDB(B0, 1, 0); PG8_SCHED; PG8_LDA(At, 1, 0); PG8_STAGE(PG8_SA(0, 1), a2 + hstep, voffA);
            PG8_WAIT_L(8); PG8_BAR; PG8_WAIT_L(0); PG8_MMA(0, 0, At, B0); PG8_BAR; PG8_SCHED;
            PG8_LDB(B1, 1, 1); PG8_STAGE(PG8_SB(1, 0), b3, voffB);
            PG8_BAR; PG8_WAIT_L(0); PG8_MMA(0, 1, At, B1); PG8_BAR;
            PG8_LDA(At, 1, 1); PG8_STAGE(PG8_SA(1, 0), a3, voffA);
            PG8_BAR; PG8_WAIT_L(0); PG8_MMA(1, 0, At, B0); PG8_BAR; PG8_SCHED;
            PG8_STAGE(PG8_SB(1, 1), b3 + hstep, voffB);
            PG8_WAIT_V(6); PG8_BAR; PG8_MMA(1, 1, At, B1); PG8_BAR;
            }
        }
        if constexpr (ALIGN_EPI) { if (wr == 0) PG8_BAR; }
        if constexpr (!Epi::AFTER_DRAIN) { E(acc, cur, wr, wc, fr, fq); S.done(cur); }
        if (!has_next) break;
#pragma unroll
        for (int a = 0; a < 2; ++a)
#pragma unroll
            for (int b = 0; b < 2; ++b)
#pragma unroll
                for (int m = 0; m < 4; ++m)
#pragma unroll
                    for (int n = 0; n < 2; ++n) acc[a][b][m][n] = (f32x4){0.f, 0.f, 0.f, 0.f};
        cur = nxt; cA = nA; cB = nB; ++ui;
        if constexpr (ALIGN_EPI) { if (wr == 1) PG8_BAR; }
    }
    PG8_WAIT_V(0);
    if constexpr (!ALIGN_EPI) { if (wr == 0) PG8_BAR; }
    PG8_BAR;
    if constexpr (Epi::AFTER_DRAIN) { E.fused(acc, cur, wr, wc, fr, fq, lds, wid, lane); S.done(cur); }
#undef PG8_SA
#undef PG8_SB
#undef PG8_STAGE
#undef PG8_LDA
#undef PG8_LDB
#undef PG8_MMA
#undef PG8_WAIT_V
#undef PG8_WAIT_L
#undef PG8_BAR
#undef PG8_SCHED
}
}

#define GAS __attribute__((address_space(1)))
#define LAS __attribute__((address_space(3)))
typedef unsigned short bf16;
typedef short bf16x8 __attribute__((ext_vector_type(8)));
typedef short s16x4 __attribute__((ext_vector_type(4)));
typedef float f32x4 __attribute__((ext_vector_type(4)));
typedef float f32x16 __attribute__((ext_vector_type(16)));
typedef unsigned u32x4 __attribute__((ext_vector_type(4)));
typedef unsigned u32x2 __attribute__((ext_vector_type(2)));
typedef GAS unsigned gu32;

constexpr int NWAVES = 8, NTHR = 512;
constexpr int D = 1024, NB = 8, SEQ = 2048, DB = 32, DS = 4, PAST = 16384;
constexpr int MP = NB * SEQ, MS = DB * DS, MR = MP + MS, M = 16640;
constexpr int NPADW = 5632;
constexpr float EPS = 1e-6f;
constexpr float LOG2E = 1.4426950408889634f;
constexpr float QSCALE = 0.125f * LOG2E;

constexpr size_t O_Y = 0;
constexpr size_t SZ_PKV = (size_t)MP * 128, SZ_PW = (size_t)NB * 512 * 128, SZ_SKV = (size_t)MS * 128, SZ_SW = (size_t)DB * 512 * 128;
constexpr size_t O_PKC = (size_t)MR * D, O_PVC = O_PKC + SZ_PKV, O_PKS = O_PVC + SZ_PKV, O_PVS = O_PKS + SZ_PKV;
constexpr size_t O_PKW = O_PVS + SZ_PKV, O_PVW = O_PKW + SZ_PW, O_PCONV = O_PVW + SZ_PW;
constexpr size_t O_SKC = O_PCONV + (size_t)NB * 30 * 512, O_SVC = O_SKC + SZ_SKV, O_SKS = O_SVC + SZ_SKV, O_SVS = O_SKS + SZ_SKV;
constexpr size_t O_SKW = O_SVS + SZ_SKV, O_SVW = O_SKW + SZ_SW, O_SCONV = O_SVW + SZ_SW, O_END = O_SCONV + (size_t)DB * 30 * 512;

constexpr size_t MiB = 1u << 20;
constexpr size_t WS_CTL = 0, CTL_ZERO_BYTES = 128 * 1024;
constexpr size_t WS_WIN_T = 2 * MiB, WS_PW_T = 14 * MiB, WS_WPA_T = 15 * MiB, WS_WPB_T = 16 * MiB, WS_WO_T = 17 * MiB;
constexpr size_t WS_W1_T = 19 * MiB;
constexpr size_t WS_W2_T = WS_W1_T + 512 * 1024;
constexpr size_t WS_PEH = WS_W2_T + 16 * 1024;
constexpr size_t WS_KCP = 20 * MiB;
constexpr size_t WS_VCPT = WS_KCP + 256 * 1024;
constexpr size_t WS_KCS = 21 * MiB, WS_VCS = 37 * MiB;
constexpr size_t WS_XN = 64 * MiB, WS_QB = 97 * MiB, WS_KS = 114 * MiB, WS_KW = 119 * MiB, WS_VST = 124 * MiB, WS_VWT = 128 * MiB;
constexpr size_t WS_GA = 132 * MiB, WS_U = 149 * MiB, WS_GB = 166 * MiB, WS_MG = 183 * MiB, WS_GN = 248 * MiB, WS_APW = 251 * MiB, WS_CB = 268 * MiB;
constexpr size_t WS_OA = 285 * MiB, WS_H = 302 * MiB, WS_T1 = 335 * MiB, WS_RSS = 368 * MiB, WS_END = 530 * MiB;
constexpr int CW_BAR = 4096;
constexpr int CW_QATT = 16384;

constexpr int RING_BYTES = 131072, LDSCTL_OFF = RING_BYTES, MISC_OFF = LDSCTL_OFF + 320, LDS_BYTES = 147456;

typedef float f32x2_t __attribute__((ext_vector_type(2))); typedef __bf16 bf16x2_t __attribute__((ext_vector_type(2)));
__device__ __forceinline__ unsigned pk2(float lo, float hi) { f32x2_t v = {lo, hi}; bf16x2_t b = __builtin_convertvector(v, bf16x2_t); return __builtin_bit_cast(unsigned, b); }
__device__ __forceinline__ float bf2f(unsigned short v) { return __uint_as_float((unsigned)v << 16); }
__device__ __forceinline__ float fexp2(float x) { return __builtin_amdgcn_exp2f(x); }
__device__ __forceinline__ float frcp(float x) { return __builtin_amdgcn_rcpf(x); }
__device__ __forceinline__ float sigmoidf_(float x) { return frcp(1.f + fexp2(-x * LOG2E)); }
__device__ __forceinline__ float siluf_(float x) { return x * sigmoidf_(x); }
__device__ __forceinline__ float wave_sum(float v) {
#pragma unroll
    for (int o = 1; o < 64; o <<= 1) v += __shfl_xor(v, o);
    return v;
}
__device__ __forceinline__ int crow(int i, int hi) { return (i & 3) + 8 * (i >> 2) + 4 * hi; }
__device__ __forceinline__ f32x16 mfma32(bf16x8 a, bf16x8 b, f32x16 c) { return __builtin_amdgcn_mfma_f32_32x32x16_bf16(a, b, c, 0, 0, 0); }
__device__ __forceinline__ bf16x8 pack8(float a0, float a1, float a2, float a3, float a4, float a5, float a6, float a7) {
    u32x4 w; w.x = pk2(a0, a1); w.y = pk2(a2, a3); w.z = pk2(a4, a5); w.w = pk2(a6, a7); return __builtin_bit_cast(bf16x8, w);
}
__device__ __forceinline__ bf16x8 pack8v(f32x4 a, f32x4 b) { return pack8(a.x, a.y, a.z, a.w, b.x, b.y, b.z, b.w); }

#define XB_TMO      128
#define XB_XCNT(j)  (256  + 64 * (j))
#define XB_XSUB(j)  (1280 + 64 * (j))
#define XB_XGEN(j)  (2304 + 64 * (j))
#define XB_TOP      3328
#define XB_TOPGEN   3392
#define XCD_BAR_WORDS 3456
#define XB_SPIN_CAP (1u << 18)
__device__ __forceinline__ unsigned xb_ld(unsigned* p)              { return __hip_atomic_load(p, __ATOMIC_RELAXED, __HIP_MEMORY_SCOPE_AGENT); }
__device__ __forceinline__ unsigned xb_add(unsigned* p, unsigned v) { return __hip_atomic_fetch_add(p, v, __ATOMIC_RELAXED, __HIP_MEMORY_SCOPE_AGENT); }
__device__ __forceinline__ unsigned xb_xcc_id() { return (unsigned)__builtin_amdgcn_s_getreg((3 << 11) | 20) & 0xFu; }
#define XB_SPIN(cond, bar) do { unsigned _sp = 0; while (cond) { __builtin_amdgcn_s_sleep(1); \
    if ((++_sp & 255u) == 0u) { if (xb_ld(&(bar)[XB_TMO])) break; if (_sp > XB_SPIN_CAP) { atomicAdd(&(bar)[XB_TMO], 1u); break; } } } } while (0)
struct XcdBarrier { unsigned* bar; unsigned x; volatile LAS unsigned* st; };
__device__ __forceinline__ XcdBarrier xcd_barrier_post(unsigned* bar, volatile LAS unsigned* st) {
    XcdBarrier b; b.bar = bar; b.x = xb_xcc_id(); b.st = st;
    if (threadIdx.x == 0) (void)xb_add(&bar[XB_XCNT(b.x)], 1u);
    return b;
}
__device__ __forceinline__ void xcd_barrier_complete(unsigned* bar, unsigned x, unsigned& nloc, unsigned& nx) {
    const unsigned G = gridDim.x * gridDim.y * gridDim.z;
    unsigned sum, cnt, mine, sp = 0u;
    for (;;) {
        sum = 0u; cnt = 0u; mine = 0u;
#pragma unroll
        for (unsigned j = 0; j < 16; ++j) { const unsigned c = xb_ld(&bar[XB_XCNT(j)]); sum += c; cnt += (c > 0u) ? 1u : 0u; mine = (j == x) ? c : mine; }
        if (sum == G) break;
        __builtin_amdgcn_s_sleep(1);
        if ((++sp & 255u) == 0u) { if (xb_ld(&bar[XB_TMO])) break; if (sp > XB_SPIN_CAP) { atomicAdd(&bar[XB_TMO], 1u); break; } }
    }
    nloc = mine > 0u ? mine : 1u; nx = cnt > 0u ? cnt : 1u;
}
__device__ __forceinline__ void xcd_barrier(const XcdBarrier& b) {
    asm volatile("s_waitcnt vmcnt(0)" ::: "memory");
    __syncthreads();
    if (threadIdx.x == 0) {
        unsigned* bar = b.bar;
        __builtin_amdgcn_s_waitcnt(0);
        unsigned nloc = b.st[0], nx = b.st[1];
        if (nloc == 0u) { xcd_barrier_complete(bar, b.x, nloc, nx); b.st[0] = nloc; b.st[1] = nx; }
        const unsigned old = xb_add(&bar[XB_XSUB(b.x)], 1u);
        const unsigned gen = old / nloc;
        if (old + 1u == (gen + 1u) * nloc) {
            __builtin_amdgcn_fence(__ATOMIC_RELEASE, "agent");
            asm volatile("s_waitcnt vmcnt(0)" ::: "memory");
            const unsigned og = xb_add(&bar[XB_TOP], 1u);
            const unsigned tg = og / nx;
            if (og + 1u == (tg + 1u) * nx) xb_add(&bar[XB_TOPGEN], 1u);
            else XB_SPIN(xb_ld(&bar[XB_TOPGEN]) == tg, bar);
            __builtin_amdgcn_fence(__ATOMIC_ACQUIRE, "agent");
            xb_add(&bar[XB_XGEN(b.x)], 1u);
            asm volatile("s_waitcnt vmcnt(0)" ::: "memory");
        } else {
            XB_SPIN(xb_ld(&bar[XB_XGEN(b.x)]) == gen, bar);
            __builtin_amdgcn_fence(__ATOMIC_ACQUIRE, "agent");
            asm volatile("s_waitcnt vmcnt(0)" ::: "memory");
        }
    }
    __syncthreads();
}

struct Frame {
    LAS unsigned char* lds;
    volatile LAS unsigned* MISC;
    gu32* ctl;
    int tid, lane, wave, vcu, G;
    const float* in[28];
    float* out;
    unsigned char* ws;
};
#define IN_F(k) ((const float*)F.in[k])
enum { I_XP = 0, I_XS, I_CKC, I_CVC, I_CKS, I_CVS, I_CKW, I_CVW, I_SCONV, I_PT, I_LNG, I_WIN, I_PEK, I_W1K, I_W2K, I_PEV, I_W1V, I_W2V, I_DWK, I_DWB, I_CLNG, I_CLNB, I_PWW, I_PWB, I_WPA, I_WPB, I_WO, I_FING };

__device__ __forceinline__ int colmap_in(int n) {
    if (n < 1280) return n;
    if (n < 1792) return 1304 + (n - 1280);
    if (n < 2816) { const int t = (n - 1792) >> 8, w = (n - 1792) & 255; return (w < 128) ? (1816 + 128 * t + w) : (2328 + 128 * t + (w - 128)); }
    if (n < 3328) return 2840 + (n - 2816);
    if (n < 5376) return 3352 + (n - 3328);
    if (n < 5400) return 1280 + (n - 5376);
    return -1;
}

template <bool MAPPED>
__device__ __forceinline__ void p0_transpose_item(const float* W, int ldS, bf16* WT, int ldD, int k0, int n0, LAS float* scr, int lane) {
    int c = n0 + (lane & 31); if (MAPPED) c = colmap_in(c);
    float wv[32];
#pragma unroll
    for (int i = 0; i < 32; ++i) { const int kk = 2 * i + (lane >> 5); wv[i] = (c >= 0) ? W[(size_t)(k0 + kk) * ldS + c] : 0.f; }
#pragma unroll
    for (int i = 0; i < 32; ++i) { const int kk = 2 * i + (lane >> 5); scr[kk * 33 + (lane & 31)] = wv[i]; }
    asm volatile("s_waitcnt lgkmcnt(0)" ::: "memory");
    const int ch = lane & 7;
#pragma unroll
    for (int j = 0; j < 4; ++j) { const int n = (lane >> 3) + 8 * j; const LAS float* s = scr + (8 * ch) * 33 + n;
        u32x4 o; o.x = pk2(s[0 * 33], s[1 * 33]); o.y = pk2(s[2 * 33], s[3 * 33]); o.z = pk2(s[4 * 33], s[5 * 33]); o.w = pk2(s[6 * 33], s[7 * 33]);
        *(u32x4*)(WT + (size_t)(n0 + n) * ldD + k0 + 8 * ch) = o; }
    asm volatile("s_waitcnt lgkmcnt(0)" ::: "memory");
}

constexpr int CMP_BS = 128 * 144;
constexpr int CMP_AS_OFF = 2 * CMP_BS, CMP_AS = 8192;
__device__ __forceinline__ void compress_finalize(Frame& F, f32x16 (&acc)[4], int tz, int bb, int g, int ct, bool samp, int nblk, LAS unsigned char* hs, int r32, int h) {
    const bf16* W2T = (const bf16*)(F.ws + WS_W2_T); const float* PEH = (const float*)(F.ws + WS_PEH);
#pragma unroll
            for (int n = 0; n < 2; ++n) {
                const float pe = PEH[tz * 64 + 32 * n + r32];
                float sh[16];
#pragma unroll
                for (int a = 0; a < 4; ++a) {
                    sh[4 * a] = acc[n + 2][4 * a + 1]; sh[4 * a + 1] = acc[n + 2][4 * a + 2]; sh[4 * a + 2] = acc[n + 2][4 * a + 3];
                    const float nxt = (a < 3) ? acc[n + 2][(a < 3) ? 4 * a + 4 : 0] : 0.f;
                    const float snd = h ? acc[n + 2][4 * a] : nxt;
                    sh[4 * a + 3] = __shfl_xor(snd, 32);
                }
#pragma unroll
                for (int i = 0; i < 16; ++i) { const float hv = pe + acc[n][i] + sh[i]; const float sv = siluf_(hv);
                    *(LAS unsigned short*)(hs + crow(i, h) * 144 + (32 * n + r32) * 2) = (unsigned short)(pk2(sv, 0.f) & 0xffffu); }
            }
            asm volatile("s_waitcnt lgkmcnt(0)" ::: "memory");
            f32x16 o2[2]; o2[0] = (f32x16)(0.f); o2[1] = (f32x16)(0.f);
#pragma unroll
            for (int s = 0; s < 4; ++s) {
                const bf16x8 a = *(const LAS bf16x8*)(hs + r32 * 144 + s * 32 + h * 16);
#pragma unroll
                for (int dt = 0; dt < 2; ++dt) { const bf16x8 b = *(const bf16x8*)(W2T + ((size_t)tz * 64 + 32 * dt + r32) * 64 + 16 * s + 8 * h); o2[dt] = mfma32(a, b, o2[dt]); }
            }
#pragma unroll
            for (int dt = 0; dt < 2; ++dt)
#pragma unroll
                for (int i = 0; i < 16; ++i) {
                    const int row = crow(i, h), bi = 31 * ct + row, d = 32 * dt + r32;
                    if (row < 31 && bi < nblk) {
                        if (samp) __builtin_nontemporal_store(o2[dt][i], (float*)(F.ws + (tz ? WS_VCS : WS_KCS)) + ((size_t)bb * 1024 + bi) * 128 + g * 64 + d);
                        else if (tz == 0) ((bf16*)(F.ws + WS_KCP))[((size_t)(bb * 2 + g) * 128 + bi) * 64 + d] = (bf16)(pk2(o2[dt][i], 0.f) & 0xffffu);
                        else ((bf16*)(F.ws + WS_VCPT))[((size_t)(bb * 2 + g) * 64 + d) * 128 + bi] = (bf16)(pk2(o2[dt][i], 0.f) & 0xffffu);
                    }
                }
}

constexpr int CMP_NT_S = 2 * DB * 2 * 33, CMP_NT_P = 2 * NB * 2 * 5, CMP_NT = CMP_NT_S + CMP_NT_P, CMP_TAIL_CUS = (CMP_NT % 2048 + 7) / 8;
__device__ __forceinline__ void compress_jobs(Frame& F, const int jstart, const int jend) {
    const int lane = F.lane, wave = F.wave, r32 = lane & 31, h = lane >> 5, tid = F.tid, cu = F.vcu, ncu = F.G;
    const bf16* W1T = (const bf16*)(F.ws + WS_W1_T); const bf16* W2T = (const bf16*)(F.ws + WS_W2_T); const float* PEH = (const float*)(F.ws + WS_PEH);
    const int* pt = (const int*)F.in[I_PT];
    LAS unsigned char* lds = F.lds;
    constexpr int CMP_FULL = (CMP_NT / 2048) * 2048;
    static_assert(CMP_FULL <= CMP_NT_S && (CMP_NT_S / 2) % 8 == 0, "full jobs hold sample wave-tiles of a single tensor");
    const int q4 = lane >> 4, pc = lane & 15;
    LAS unsigned char* bdst = lds + (tid >> 2) * 144 + (tid & 3) * 32;
    LAS unsigned char* AS = lds + CMP_AS_OFF + wave * CMP_AS;
    constexpr int nblk = 1023;
    u32x4 breg[2]; f32x4 ar0[8], ar1[8], ar2[8];
    int tz = 0, bb = 0, g = 0, ct = 0, j0 = 0; const float* abase = nullptr; const bf16* bsrc = nullptr; unsigned rb[8];
#define CMP_SETUP(JOB) do { \
        const int wt_ = 8 * (JOB) + wave;                        \
        j0 = (cu * 5 + ((JOB) / ncu) * 3) & 15;                  \
        tz = (8 * (JOB)) / (CMP_NT_S / 2);                       \
        { const int r1 = wt_ % (CMP_NT_S / 2); bb = r1 / 66; const int r2 = r1 % 66; ct = r2 >> 1; g = r2 & 1; } \
        abase = IN_F(tz ? I_CVC : I_CKC) + g * 64 + 4 * pc; \
        _Pragma("unroll") for (int i = 0; i < 8; ++i) { int c = 31 * ct + 4 * i + q4; if (c > 1023) c = 1023; const int page = pt[bb * 128 + (c >> 3)]; rb[i] = (unsigned)((page * 128 + (c & 7) * 16) * 128); } \
        bsrc = W1T + ((size_t)tz * 128 + (tid >> 2)) * 1024 + (tid & 3) * 16; \
        _Pragma("unroll") for (int q = 0; q < 2; ++q) breg[q] = *(const u32x4*)(bsrc + (j0 & 15) * 64 + q * 8); \
        _Pragma("unroll") for (int i = 0; i < 8; ++i) ar0[i] = __builtin_nontemporal_load((const f32x4*)(abase + rb[i] + (j0 & 15) * 128)); \
        _Pragma("unroll") for (int i = 0; i < 8; ++i) ar1[i] = __builtin_nontemporal_load((const f32x4*)(abase + rb[i] + ((j0 + 1) & 15) * 128)); \
        _Pragma("unroll") for (int i = 0; i < 8; ++i) ar2[i] = __builtin_nontemporal_load((const f32x4*)(abase + rb[i] + ((j0 + 2) & 15) * 128)); \
    } while (0)
    const int jlim = (jend < CMP_FULL / 8) ? jend : CMP_FULL / 8;
    int job = jstart;
    if (job < jlim) CMP_SETUP(job);
    while (job < jlim) {
        f32x16 acc[4];
#pragma unroll
        for (int n = 0; n < 4; ++n) acc[n] = (f32x16)(0.f);
        __syncthreads();
#pragma unroll
        for (int q = 0; q < 2; ++q) *(LAS u32x4*)(bdst + q * 16) = breg[q];
#define CMP_SLICE(J, AR) do { \
            __syncthreads(); \
            const int st_ = ((J) & 1) * CMP_BS; \
            if ((J) + 1 < 16) { _Pragma("unroll") for (int q = 0; q < 2; ++q) breg[q] = *(const u32x4*)(bsrc + ((j0 + (J) + 1) & 15) * 64 + q * 8); } \
            _Pragma("unroll") for (int i = 0; i < 8; ++i) *(LAS f32x4*)(AS + (4 * i + q4) * 256 + ((pc ^ ((4 * i + q4) & 15)) * 16)) = AR[i]; \
            if ((J) + 3 < 16) { _Pragma("unroll") for (int i = 0; i < 8; ++i) AR[i] = __builtin_nontemporal_load((const f32x4*)(abase + rb[i] + ((j0 + (J) + 3) & 15) * 128)); } \
            const LAS unsigned char* bl = lds + st_ + r32 * 144 + h * 16; \
            _Pragma("unroll") for (int s = 0; s < 4; ++s) { const f32x4 x0 = *(const LAS f32x4*)(AS + r32 * 256 + (((4 * s + 2 * h) ^ (r32 & 15)) * 16)), x1 = *(const LAS f32x4*)(AS + r32 * 256 + (((4 * s + 2 * h + 1) ^ (r32 & 15)) * 16)); const bf16x8 af = pack8v(x0, x1); \
                _Pragma("unroll") for (int n = 0; n < 4; ++n) { const bf16x8 bf = *(const LAS bf16x8*)(bl + n * 32 * 144 + s * 32); acc[n] = mfma32(af, bf, acc[n]); } } \
            if ((J) + 1 < 16) { LAS unsigned char* bd2 = bdst + (((J) + 1) & 1) * CMP_BS; _Pragma("unroll") for (int q = 0; q < 2; ++q) *(LAS u32x4*)(bd2 + q * 16) = breg[q]; } \
        } while (0)
        for (int j = 0; j < 15; j += 3) { CMP_SLICE(j, ar0); CMP_SLICE(j + 1, ar1); CMP_SLICE(j + 2, ar2); }
        CMP_SLICE(15, ar0);
#undef CMP_SLICE
        const int ftz = tz, fbb = bb, fg = g, fct = ct;
        job += ncu;
        if (job < jlim) CMP_SETUP(job);
        compress_finalize(F, acc, ftz, fbb, fg, fct, true, nblk, AS, r32, h);
    }
#undef CMP_SETUP
    __syncthreads();
}
__device__ __forceinline__ void compress_tail(Frame& F) {
    const int lane = F.lane, wave = F.wave, r32 = lane & 31, h = lane >> 5, cu = F.vcu, ncu = F.G;
    const bf16* W1T = (const bf16*)(F.ws + WS_W1_T);
    const int* pt = (const int*)F.in[I_PT];
    LAS unsigned char* lds = F.lds;
    constexpr int CMP_FULL = (CMP_NT / 2048) * 2048;
    constexpr int nrem = CMP_NT - CMP_FULL;
    for (int base = cu; base < nrem; base += 2 * ncu) {
        const bool two = base + ncu < nrem;
        const int wpt = two ? 4 : 8, sub = two ? (wave >> 2) : 0, kp = two ? (wave & 3) : wave, nsl = 16 / wpt, sl0 = kp * nsl;
        const int wt = CMP_FULL + base + sub * ncu;
        const bool samp = wt < CMP_NT_S;
        int tz, bb, g, ct;
        if (samp) { tz = wt / (CMP_NT_S / 2); const int r1 = wt % (CMP_NT_S / 2); bb = r1 / 66; const int r2 = r1 % 66; ct = r2 >> 1; g = r2 & 1; }
        else { const int w2 = wt - CMP_NT_S; tz = w2 / (CMP_NT_P / 2); const int r1 = w2 % (CMP_NT_P / 2); bb = r1 / 10; const int r2 = r1 % 10; ct = r2 >> 1; g = r2 & 1; }
        const int nchunk = samp ? 1024 : 128, nblk = samp ? 1023 : 127;
        int c = 31 * ct + r32; if (c > nchunk - 1) c = nchunk - 1;
        const float* arow;
        if (samp) { const int page = pt[bb * 128 + (c >> 3)]; arow = IN_F(tz ? I_CVC : I_CKC) + ((size_t)page * 128 + (c & 7) * 16) * 128 + g * 64 + 8 * h; }
        else arow = F.out + (tz ? O_PVC : O_PKC) + ((size_t)bb * SEQ + c * 16) * 128 + g * 64 + 8 * h;
        f32x16 acc[4];
#pragma unroll
        for (int n = 0; n < 4; ++n) acc[n] = (f32x16)(0.f);
        f32x4 arA[8], arB[8];
#define CMP_TLOAD(AR, SL) do { _Pragma("unroll") for (int s = 0; s < 4; ++s) { AR[2 * s] = *(const f32x4*)(arow + (SL) * 128 + 16 * s); AR[2 * s + 1] = *(const f32x4*)(arow + (SL) * 128 + 16 * s + 4); } } while (0)
#define CMP_TMMA(AR, SL) do { const bf16* bp = W1T + ((size_t)tz * 128 + r32) * 1024 + (SL) * 64 + 8 * h; \
            bf16x8 bfr[4][4];                                  \
            _Pragma("unroll") for (int s = 0; s < 4; ++s) _Pragma("unroll") for (int n = 0; n < 4; ++n) bfr[s][n] = *(const bf16x8*)(bp + (size_t)n * 32 * 1024 + 16 * s); \
            _Pragma("unroll") for (int s = 0; s < 4; ++s) { const bf16x8 af = pack8v(AR[2 * s], AR[2 * s + 1]); \
                _Pragma("unroll") for (int n = 0; n < 4; ++n) acc[n] = mfma32(af, bfr[s][n], acc[n]); } } while (0)
        CMP_TLOAD(arA, sl0); CMP_TLOAD(arB, sl0 + 1);
#pragma unroll 1
        for (int jj = 0; jj < nsl; jj += 2) {
            CMP_TMMA(arA, sl0 + jj);     if (jj + 2 < nsl) CMP_TLOAD(arA, sl0 + jj + 2);
            CMP_TMMA(arB, sl0 + jj + 1); if (jj + 3 < nsl) CMP_TLOAD(arB, sl0 + jj + 3);
        }
#undef CMP_TLOAD
#undef CMP_TMMA
        LAS float* R = (LAS float*)lds;
        __syncthreads();
#pragma unroll
        for (int n = 0; n < 4; ++n)
#pragma unroll
            for (int i = 0; i < 16; ++i) (R + wave * 4096 + lane)[(n * 16 + i) * 64] = acc[n][i];
        __syncthreads();
        if (kp == 0) {
#pragma unroll 1
            for (int w = 1; w < wpt; ++w) { const LAS float* Rw = R + (wave + w) * 4096 + lane;
#pragma unroll
                for (int n = 0; n < 4; ++n)
#pragma unroll
                    for (int i = 0; i < 16; ++i) acc[n][i] += Rw[(n * 16 + i) * 64]; }
        }
        __syncthreads();
        if (kp == 0) compress_finalize(F, acc, tz, bb, g, ct, samp, nblk, lds + wave * 16384, r32, h);
    }
    __syncthreads();
}

__device__ __forceinline__ void p0_prologue(Frame& F, const int part, const int cu, const int ncu) {
    const int gw = cu * NWAVES + F.wave, NGW = ncu * NWAVES, lane = F.lane;
    {
        LAS float* scr = (LAS float*)(F.lds + F.wave * 8704);
        constexpr int I_IN = 16 * (NPADW / 32), I_PW = 8 * 16, I_PA = 8 * 32, I_OO = 16 * 32, I_W1 = 16 * 2, I_W2 = 2;
        constexpr int NITEMS = I_IN + I_PW + 2 * I_PA + I_OO + 4 * I_W1 + 2 * I_W2;
        constexpr int I_B = I_IN + I_PW + 4 * I_W1 + 2 * I_W2;
        for (int it = (part == 0 ? 0 : part == 1 ? I_IN : I_B) + gw; it < (part == 0 ? I_IN : part == 1 ? I_B : NITEMS); it += NGW) {
            int r = it;
            if (r < I_IN) { p0_transpose_item<true>(IN_F(I_WIN), 5400, (bf16*)(F.ws + WS_WIN_T), 1024, 64 * (r / (NPADW / 32)), 32 * (r % (NPADW / 32)), scr, lane); continue; } r -= I_IN;
            if (r < I_PW) { p0_transpose_item<false>(IN_F(I_PWW), 512, (bf16*)(F.ws + WS_PW_T), 512, 64 * (r / 16), 32 * (r % 16), scr, lane); continue; } r -= I_PW;
            if (r < 4 * I_W1) { const int tz = r / (2 * I_W1), rr = (r / I_W1) & 1, q = r % I_W1;
                p0_transpose_item<false>(IN_F(tz ? I_W1V : I_W1K) + (size_t)rr * 1024 * 64, 64, (bf16*)(F.ws + WS_W1_T) + ((size_t)tz * 128 + rr * 64) * 1024, 1024, 64 * (q / 2), 32 * (q % 2), scr, lane); continue; } r -= 4 * I_W1;
            if (r < 2 * I_W2) { const int tz = r / I_W2, q = r % I_W2;
              p0_transpose_item<false>(IN_F(tz ? I_W2V : I_W2K), 64, (bf16*)(F.ws + WS_W2_T) + (size_t)tz * 4096, 64, 0, 32 * q, scr, lane); continue; } r -= 2 * I_W2;
            if (r < I_PA) { p0_transpose_item<false>(IN_F(I_WPA), 1024, (bf16*)(F.ws + WS_WPA_T), 512, 64 * (r / 32), 32 * (r % 32), scr, lane); continue; } r -= I_PA;
            if (r < I_PA) { p0_transpose_item<false>(IN_F(I_WPB), 1024, (bf16*)(F.ws + WS_WPB_T), 512, 64 * (r / 32), 32 * (r % 32), scr, lane); continue; } r -= I_PA;
            if (r < I_OO) { p0_transpose_item<false>(IN_F(I_WO), 1024, (bf16*)(F.ws + WS_WO_T), 1024, 64 * (r / 32), 32 * (r % 32), scr, lane); continue; }
        }
    }
    if (part == 1) for (int it = NGW - 1 - gw; it < 128; it += NGW) {
        const int tz = it >> 6, hh = it & 63; const float* pe = IN_F(tz ? I_PEV : I_PEK); const float* w1 = IN_F(tz ? I_W1V : I_W1K);
        float s = 0.f;
        for (int i = 0; i < 32; ++i) { const int k = lane + 64 * i; s += pe[k] * w1[(size_t)k * 64 + hh]; }
        s = wave_sum(s);
        if (lane == 0) ((float*)(F.ws + WS_PEH))[it] = s;
    }
    if (!part) {
        const float* lg = IN_F(I_LNG);
        f32x4 gv[4];
#pragma unroll
        for (int j = 0; j < 4; ++j) gv[j] = *(const f32x4*)(lg + (lane + 64 * j) * 4);
        for (int m0 = gw; m0 < M; m0 += 4 * NGW) {
            f32x4 v[4][4]; float ss[4];
#pragma unroll
            for (int q = 0; q < 4; ++q) { const int m = m0 + q * NGW; ss[q] = 0.f;
                if (m < MR) { const float* xr = (m < MP) ? IN_F(I_XP) + (size_t)m * D : IN_F(I_XS) + (size_t)(m - MP) * D;
#pragma unroll
                    for (int j = 0; j < 4; ++j) v[q][j] = __builtin_nontemporal_load((const f32x4*)(xr + (lane + 64 * j) * 4)); }
                else {
#pragma unroll
                    for (int j = 0; j < 4; ++j) v[q][j] = (f32x4){0.f, 0.f, 0.f, 0.f}; } }
#pragma unroll
            for (int q = 0; q < 4; ++q) {
#pragma unroll
                for (int j = 0; j < 4; ++j) ss[q] += (v[q][j].x * v[q][j].x + v[q][j].y * v[q][j].y) + (v[q][j].z * v[q][j].z + v[q][j].w * v[q][j].w); }
#pragma unroll
            for (int q = 0; q < 4; ++q) { const int m = m0 + q * NGW; if (m >= M) continue;
                const float rstd = 1.0f / sqrtf(wave_sum(ss[q]) * (1.f / D) + EPS);
                u32x2* o8 = (u32x2*)(F.ws + WS_XN + (size_t)m * D * 2) + lane;
#pragma unroll
                for (int j = 0; j < 4; ++j) { const f32x4 y = v[q][j] * rstd * gv[j]; o8[64 * j] = (m < MR) ? (u32x2){pk2(y.x, y.y), pk2(y.z, y.w)} : (u32x2){0u, 0u}; } }
        }
    }
    if (part == 2) {
        const int gt = cu * NTHR + F.tid, NGT = ncu * NTHR;
        constexpr int W4 = 508 * 128 / 4, C4 = 26 * 512 / 4;
        for (int i0 = gt; i0 < 2 * DB * W4; i0 += 4 * NGT) { f32x4 v[4];
#pragma unroll
            for (int k = 0; k < 4; ++k) { const int i = i0 + k * NGT; if (i < 2 * DB * W4) { const int tz = i / (DB * W4), r = i % (DB * W4), b = r / W4, q = r % W4; v[k] = __builtin_nontemporal_load((const f32x4*)(IN_F(tz ? I_CVW : I_CKW) + ((size_t)b * 512 + 4) * 128) + q); } }
#pragma unroll
            for (int k = 0; k < 4; ++k) { const int i = i0 + k * NGT; if (i < 2 * DB * W4) { const int tz = i / (DB * W4), r = i % (DB * W4), b = r / W4, q = r % W4; __builtin_nontemporal_store(v[k], (f32x4*)(F.out + (tz ? O_SVW : O_SKW) + (size_t)b * 512 * 128) + q); } } }
        for (int i = gt; i < DB * C4; i += NGT) { const int b = i / C4, q = i % C4;
            ((f32x4*)(F.out + O_SCONV + (size_t)b * 30 * 512))[q] = ((const f32x4*)(IN_F(I_SCONV) + ((size_t)b * 30 + 4) * 512))[q]; }
    }
    if (part == 1) {
        const int gt = cu * NTHR + F.tid, NGT = ncu * NTHR;
        for (int i = gt; i < NB * 2 * 64; i += NGT) { ((bf16*)(F.ws + WS_KCP))[((size_t)(i >> 6) * 128 + 127) * 64 + (i & 63)] = 0; ((bf16*)(F.ws + WS_VCPT))[(size_t)i * 128 + 127] = 0; }
        for (int i = gt; i < DB * 128; i += NGT) { ((float*)(F.ws + WS_KCS))[((size_t)(i >> 7) * 1024 + 1023) * 128 + (i & 127)] = 0.f; ((float*)(F.ws + WS_VCS))[((size_t)(i >> 7) * 1024 + 1023) * 128 + (i & 127)] = 0.f; }
    }
}

struct EpiIn {
    static constexpr bool PERM = true, AFTER_DRAIN = false;
    unsigned char* ws; float* out;
    __device__ __forceinline__ void operator()(const pg8::f32x4 (&acc)[2][2][4][2], const pg8::Unit& u, int wr, int wc, int fr, int fq) const {
        const int pn = u.pn;
#pragma unroll
        for (int ai = 0; ai < 2; ++ai)
#pragma unroll
            for (int m = 0; m < 4; ++m) {
                const int r = u.pm * 256 + ai * 128 + wr * 64 + m * 16 + fr;
                const int cl = wc * 32 + 8 * fq;
                if (pn >= 7 && pn <= 10) {
                    const f32x4 a0 = acc[ai][0][m][0], a1 = acc[ai][0][m][1], g0 = acc[ai][1][m][0], g1 = acc[ai][1][m][1];
                    f32x4 u0, u1;
#pragma unroll
                    for (int e = 0; e < 4; ++e) { u0[e] = a0[e] * sigmoidf_(g0[e]); u1[e] = a1[e] * sigmoidf_(g1[e]); }
                    const int ch = 128 * (pn - 7) + cl;
                    *(u32x4*)((bf16*)(ws + WS_U) + (size_t)r * 512 + ch) = (u32x4){pk2(u0.x, u0.y), pk2(u0.z, u0.w), pk2(u1.x, u1.y), pk2(u1.z, u1.w)};
                    float* dst = nullptr;
                    if (r < MP) { const int t = r & (SEQ - 1); if (t >= SEQ - 30) dst = out + O_PCONV + ((size_t)(r >> 11) * 30 + (t - (SEQ - 30))) * 512 + ch; }
                    else if (r < MR) { const int sm = r - MP; dst = out + O_SCONV + ((size_t)(sm >> 2) * 30 + 26 + (sm & 3)) * 512 + ch; }
                    if (dst) { *(f32x4*)dst = u0; *(f32x4*)(dst + 4) = u1; }
                    continue;
                }
#pragma unroll
                for (int bj = 0; bj < 2; ++bj) {
                    const f32x4 v0 = acc[ai][bj][m][0], v1 = acc[ai][bj][m][1];
                    const int c = pn * 256 + bj * 128 + cl;
                    if (pn < 2) {
                        *(u32x4*)((bf16*)(ws + WS_QB) + (size_t)r * 512 + c) = (u32x4){pk2(v0.x * QSCALE, v0.y * QSCALE), pk2(v0.z * QSCALE, v0.w * QSCALE), pk2(v1.x * QSCALE, v1.y * QSCALE), pk2(v1.z * QSCALE, v1.w * QSCALE)};
                    } else if (pn < 5) {
                        const int set = pn - 2;
                        float* dst = nullptr;
                        if (r < MP) {
                            if (set < 2) dst = out + O_PKC + (size_t)(2 * set + bj) * SZ_PKV + (size_t)r * 128 + cl;
                            else { const int t = r & (SEQ - 1); if (t >= SEQ - 512) dst = out + O_PKW + (size_t)bj * SZ_PW + ((size_t)(r >> 11) * 512 + (t - (SEQ - 512))) * 128 + cl; }
                        } else if (r < MR) {
                            const int sm = r - MP;
                            if (set < 2) dst = out + O_SKC + (size_t)(2 * set + bj) * SZ_SKV + (size_t)sm * 128 + cl;
                            else dst = out + O_SKW + (size_t)bj * SZ_SW + ((size_t)(sm >> 2) * 512 + 508 + (sm & 3)) * 128 + cl;
                        }
                        if (dst) { *(f32x4*)dst = v0; *(f32x4*)(dst + 4) = v1; }
                        if (set >= 1) {
                            if (bj == 0) *(u32x4*)((bf16*)(ws + (set == 1 ? WS_KS : WS_KW)) + (size_t)r * 128 + cl) = (u32x4){pk2(v0.x, v0.y), pk2(v0.z, v0.w), pk2(v1.x, v1.y), pk2(v1.z, v1.w)};
                            else if (r < MP) {
                                bf16* vt = (bf16*)(ws + (set == 1 ? WS_VST : WS_VWT)) + ((size_t)(r >> 11) * 128 + cl) * SEQ + (r & (SEQ - 1));
#pragma unroll
                                for (int e = 0; e < 4; ++e) { vt[(size_t)e * SEQ] = (bf16)(pk2(v0[e], 0.f) & 0xffffu); vt[(size_t)(e + 4) * SEQ] = (bf16)(pk2(v1[e], 0.f) & 0xffffu); }
                            }
                        }
                    } else if (pn < 7 || pn == 11 || pn == 12) {
                        bf16* dstb = (pn < 7) ? (bf16*)(ws + WS_GA) + (size_t)r * 512 + (c - 1280) : (bf16*)(ws + WS_GB) + (size_t)r * 512 + (c - 2816);
                        *(u32x4*)dstb = (u32x4){pk2(siluf_(v0.x), siluf_(v0.y)), pk2(siluf_(v0.z), siluf_(v0.w)), pk2(siluf_(v1.x), siluf_(v1.y)), pk2(siluf_(v1.z), siluf_(v1.w))};
                    } else if (pn < 21) {
                        *(u32x4*)((bf16*)(ws + WS_MG) + (size_t)r * 2048 + (c - 3328)) = (u32x4){pk2(sigmoidf_(v0.x), sigmoidf_(v0.y)), pk2(sigmoidf_(v0.z), sigmoidf_(v0.w)), pk2(sigmoidf_(v1.x), sigmoidf_(v1.y)), pk2(sigmoidf_(v1.z), sigmoidf_(v1.w))};
                    } else {
                        if (bj == 0 && wc == 0) { float* dg = (float*)(ws + WS_GN) + (size_t)r * 32 + cl;
                            *(f32x4*)dg = (f32x4){sigmoidf_(v0.x), sigmoidf_(v0.y), sigmoidf_(v0.z), sigmoidf_(v0.w)}; *(f32x4*)(dg + 4) = (f32x4){sigmoidf_(v1.x), sigmoidf_(v1.y), sigmoidf_(v1.z), sigmoidf_(v1.w)}; }
                    }
                }
            }
    }
};

constexpr int CV_TILE = 0, CV_T = 65536, CV_STATS = CV_T + 65536;
__device__ __forceinline__ void conv_load(Frame& F, int u, u32x4 (&v)[8]) {
    const int tid = F.tid;
    const bool samp = u >= 512; const int bb = samp ? u - 512 : u >> 6, t0 = samp ? 0 : 32 * (u & 63);
    const bf16* U = (const bf16*)(F.ws + WS_U);
#pragma unroll
    for (int k = 0; k < 8; ++k) { const int it = tid + k * NTHR; const int i = it >> 6, c8 = (it & 63) * 8; v[k] = (u32x4){0u, 0u, 0u, 0u};
        if (it < 62 * 64) {
            if (samp) {
                if (i < 30) { const float* sp = IN_F(I_SCONV) + ((size_t)bb * 30 + i) * 512 + c8; const f32x4 a = *(const f32x4*)sp, b2 = *(const f32x4*)(sp + 4); v[k] = (u32x4){pk2(a.x, a.y), pk2(a.z, a.w), pk2(b2.x, b2.y), pk2(b2.z, b2.w)}; }
                else if (i < 34) v[k] = *(const u32x4*)(U + (size_t)(MP + bb * 4 + i - 30) * 512 + c8);
            } else { const int t = t0 - 30 + i; if (t >= 0) v[k] = *(const u32x4*)(U + ((size_t)bb * SEQ + t) * 512 + c8); } } }
}
__device__ __forceinline__ void conv_unit(Frame& F, int u, int un, u32x4 (&v)[8], const float (&kw)[31], float bias, float lg, float lb) {
    LAS unsigned short* tile = (LAS unsigned short*)(F.lds + CV_TILE);
    LAS float* T = (LAS float*)(F.lds + CV_T);
    LAS float* stats = (LAS float*)(F.lds + CV_STATS);
    const int tid = F.tid, lane = F.lane, wave = F.wave;
    const bool samp = u >= 512; const int bb = samp ? u - 512 : u >> 6, t0 = samp ? 0 : 32 * (u & 63), nt = samp ? 4 : 32;
    __syncthreads();
#pragma unroll
    for (int k = 0; k < 8; ++k) { const int it = tid + k * NTHR; if (it < 62 * 64) *(LAS u32x4*)(tile + (it >> 6) * 512 + (it & 63) * 8) = v[k]; }
    if (un >= 0) conv_load(F, un, v);
    __syncthreads();
    const int ch = tid;
    for (int hf = 0; hf < 2; ++hf) {
        if (samp && hf) break;
        float x[46];
#pragma unroll
        for (int i = 0; i < 46; ++i) x[i] = bf2f(tile[(16 * hf + i) * 512 + ch]);
        float cv[16];
#pragma unroll
        for (int t = 0; t < 16; ++t) cv[t] = bias;
#pragma unroll
        for (int i = 0; i < 46; ++i) {
#pragma unroll
            for (int t = 0; t < 16; ++t) { const int w = i - t; if (w >= 0 && w < 31) cv[t] += kw[w] * x[i]; } }
#pragma unroll
        for (int t = 0; t < 16; ++t) T[(16 * hf + t) * 512 + ch] = cv[t];
    }
    __syncthreads();
#pragma unroll
    for (int q = 0; q < 4; ++q) { const int t = wave * 4 + q; float s1 = 0.f, s2 = 0.f;
#pragma unroll
        for (int k = 0; k < 8; ++k) { const float v = T[t * 512 + lane + 64 * k]; s1 += v; s2 += v * v; }
        s1 = wave_sum(s1); s2 = wave_sum(s2);
        if (lane == 0) { const float mu = s1 * (1.f / 512.f), var = fmaxf(s2 * (1.f / 512.f) - mu * mu, 0.f); stats[t * 2] = mu; stats[t * 2 + 1] = 1.0f / sqrtf(var + EPS); } }
    __syncthreads();
#pragma unroll
    for (int t = 0; t < 32; ++t) if (t < nt) {
        const float y = (T[t * 512 + ch] - stats[t * 2]) * stats[t * 2 + 1] * lg + lb;
        tile[t * 512 + ch] = (unsigned short)(pk2(siluf_(y), 0.f) & 0xffffu);
    }
    __syncthreads();
    bf16* A = (bf16*)(F.ws + WS_APW);
    for (int it = tid; it < nt * 64; it += NTHR) { const int t = it >> 6, c8 = (it & 63) * 8;
        const size_t m = samp ? (size_t)(MP + bb * 4 + t) : (size_t)bb * SEQ + t0 + t;
        *(u32x4*)(A + m * 512 + c8) = *(const LAS u32x4*)(tile + t * 512 + c8); }
}

struct Soft { f32x16 o0, o1; float m, l; };
__device__ __forceinline__ void soft_init(Soft& s, float m0 = -1e30f) { s.o0 = (f32x16)(0.f); s.o1 = (f32x16)(0.f); s.m = m0; s.l = 0.f; }

constexpr int KT_PITCH = 144, VT_PITCH = 136, KT_BYTES = 64 * KT_PITCH, VT_BYTES = 64 * VT_PITCH, KV_STAGE = KT_BYTES + VT_BYTES;
__device__ __forceinline__ void attn_half_step(Soft& st, f32x16& p, const LAS unsigned char* Vt, int kbase, int kpos, int lo, int hi, bool en, int mm, int r32, int h) {
    if (mm == 2) {
#pragma unroll
        for (int i = 0; i < 16; ++i) { const int kp = kpos + crow(i, h); const bool ok = en && kp >= lo && kp <= hi; p[i] = ok ? p[i] : -INFINITY; }
    }
    float mx = fmaxf(p[0], p[1]);
#pragma unroll
    for (int i = 2; i < 16; ++i) mx = fmaxf(mx, p[i]);
    if (mm == 1) mx = en ? mx : -INFINITY;
    mx = fmaxf(mx, __shfl_xor(mx, 32));
    if (__any(mx > st.m + 16.f)) {
        const float mn = (mx > st.m + 16.f) ? mx : st.m, alpha = fexp2(st.m - mn);
        st.m = mn; st.l *= alpha; st.o0 *= alpha; st.o1 *= alpha;
    }
    if (__any(st.m != 0.f)) {
#pragma unroll
        for (int i = 0; i < 16; ++i) p[i] -= st.m;
    }
#pragma unroll
    for (int i = 0; i < 16; ++i) p[i] = fexp2(p[i]);
    f32x2_t s2 = {p[0], p[1]};
#pragma unroll
    for (int i = 1; i < 8; ++i) s2 += (f32x2_t){p[2 * i], p[2 * i + 1]};
    const float sum = s2.x + s2.y;
    const bool off = (mm == 1) && !en;
    st.l += off ? 0.f : sum;
#pragma unroll
    for (int s = 0; s < 2; ++s) {
        u32x4 w; w.x = pk2(p[8 * s], p[8 * s + 1]); w.y = pk2(p[8 * s + 2], p[8 * s + 3]); w.z = pk2(p[8 * s + 4], p[8 * s + 5]); w.w = pk2(p[8 * s + 6], p[8 * s + 7]);
        if (mm == 1) { w.x = off ? 0u : w.x; w.y = off ? 0u : w.y; w.z = off ? 0u : w.z; w.w = off ? 0u : w.w; }
        const bf16x8 pb = __builtin_bit_cast(bf16x8, w);
        const int ko = (kbase + 16 * s + 4 * h) * 2;
        { const s16x4 a = *(const LAS s16x4*)(Vt + r32 * VT_PITCH + ko), b = *(const LAS s16x4*)(Vt + r32 * VT_PITCH + ko + 16);
          st.o0 = mfma32((bf16x8){a[0], a[1], a[2], a[3], b[0], b[1], b[2], b[3]}, pb, st.o0); }
        { const s16x4 a = *(const LAS s16x4*)(Vt + (32 + r32) * VT_PITCH + ko), b = *(const LAS s16x4*)(Vt + (32 + r32) * VT_PITCH + ko + 16);
          st.o1 = mfma32((bf16x8){a[0], a[1], a[2], a[3], b[0], b[1], b[2], b[3]}, pb, st.o1); }
    }
}
__device__ __forceinline__ void attn_tile_lds(Soft& st, const bf16x8 (&qf)[4], const LAS unsigned char* Kt, const LAS unsigned char* Vt, int kpos0, int lo, int hi, bool en, int mm, int r32, int h) {
    f32x16 p0 = (f32x16)(0.f), p1 = (f32x16)(0.f);
#pragma unroll
    for (int s = 0; s < 4; ++s) { const bf16x8 kf = *(const LAS bf16x8*)(Kt + r32 * KT_PITCH + s * 32 + h * 16); p0 = mfma32(kf, qf[s], p0); }
#pragma unroll
    for (int s = 0; s < 4; ++s) { const bf16x8 kf = *(const LAS bf16x8*)(Kt + (32 + r32) * KT_PITCH + s * 32 + h * 16); p1 = mfma32(kf, qf[s], p1); }
    attn_half_step(st, p0, Vt, 0, kpos0, lo, hi, en, mm, r32, h);
    attn_half_step(st, p1, Vt, 32, kpos0 + 32, lo, hi, en, mm, r32, h);
}
struct KVRegs { u32x4 k, v; };
__device__ __forceinline__ void kv_load(KVRegs& r, const bf16* Kg, int ldk, const bf16* Vg, int ldv, int key0, int tid) {
    const int row = tid >> 3, ch = tid & 7;
    r.k = *(const u32x4*)(Kg + (size_t)(key0 + row) * ldk + ch * 8);
    r.v = *(const u32x4*)(Vg + (size_t)row * ldv + key0 + ch * 8);
}
__device__ __forceinline__ void kv_store(const KVRegs& r, LAS unsigned char* stage, int tid) {
    const int row = tid >> 3, ch = tid & 7;
    *(LAS u32x4*)(stage + row * KT_PITCH + ch * 16) = r.k;
    LAS u32x2* vd = (LAS u32x2*)(stage + KT_BYTES + row * VT_PITCH + ch * 16);
    vd[0] = (u32x2){r.v.x, r.v.y}; vd[1] = (u32x2){r.v.z, r.v.w};
}
template <class EnFn, class ModeFn>
__device__ __forceinline__ void attn_branch_lds(Soft& st, const bf16x8 (&qf)[4], LAS unsigned char* kv, const bf16* Kg, int ldk, const bf16* Vg, int ldv,
                                                int jlo, int jhi, unsigned tilemask, int lo, int hi, const EnFn& en, const ModeFn& mode, int tid, int r32, int h) {
    unsigned todo = tilemask & ((jhi >= 31 ? 0xffffffffu : ((1u << (jhi + 1)) - 1u))) & ~((1u << jlo) - 1u);
    if (!todo) return;
    KVRegs r; int j = __builtin_ctz(todo); todo &= todo - 1u; int buf = 0;
    kv_load(r, Kg, ldk, Vg, ldv, 64 * j, tid);
    __syncthreads();
    kv_store(r, kv, tid);
    for (;;) {
        __syncthreads();
        const int jn = todo ? __builtin_ctz(todo) : -1;
        if (jn >= 0) { todo &= todo - 1u; kv_load(r, Kg, ldk, Vg, ldv, 64 * jn, tid); }
        attn_tile_lds(st, qf, kv + buf * KV_STAGE, kv + buf * KV_STAGE + KT_BYTES, 64 * j, lo, hi, en(j), mode(j), r32, h);
        if (jn < 0) break;
        kv_store(r, kv + (buf ^ 1) * KV_STAGE, tid);
        buf ^= 1; j = jn;
    }
}
__device__ __forceinline__ void soft_finish(f32x16& a0, f32x16& a1, Soft& st, float gate) {
    const float l = st.l + __shfl_xor(st.l, 32);
    const float sc = gate / fmaxf(l, 1e-30f);
    a0 += st.o0 * sc; a1 += st.o1 * sc;
}

constexpr int PA_KV = 0, PA_PST = 2 * KV_STAGE, PA_SC = PA_PST + 128 * 64 * 4, PA_SEL = PA_SC + 32 * 64 * 4, PA_ANY = PA_SEL + 256;
__device__ __forceinline__ void attn_prompt_unit(Frame& F, int b, int g, int qb) {
    const int tid = F.tid, lane = F.lane, wave = F.wave, r32 = lane & 31, h = lane >> 5;
    const int hh = wave >> 1, qh = wave & 1, ql = 32 * qh + r32, q0 = 64 * qb, qpos = q0 + ql;
    const size_t mrow = (size_t)b * SEQ + qpos;
    LAS unsigned char* lds = F.lds;
    LAS unsigned char* kv = lds + PA_KV;
    LAS float* psT = (LAS float*)(lds + PA_PST);
    LAS float* sc = (LAS float*)(lds + PA_SC);
    LAS unsigned* sel = (LAS unsigned*)(lds + PA_SEL);
    LAS unsigned* anysel = (LAS unsigned*)(lds + PA_ANY);
    bf16x8 qf[4];
    { const bf16* qp = (const bf16*)(F.ws + WS_QB) + mrow * 512 + (g * 4 + hh) * 64 + 8 * h;
#pragma unroll
      for (int s = 0; s < 4; ++s) qf[s] = *(const bf16x8*)(qp + 16 * s); }
    const float* gn = (const float*)(F.ws + WS_GN) + mrow * 32 + g * 12 + hh * 3;
    float gc = gn[0], gs = gn[1], gw_ = gn[2];
    f32x16 a0 = (f32x16)(0.f), a1 = (f32x16)(0.f);
    if (tid < 64) sel[tid] = 0u;
    if (tid == 64) anysel[0] = 0u;
    const bf16* Kc = (const bf16*)(F.ws + WS_KCP) + (size_t)(b * 2 + g) * 128 * 64;
    const bf16* Vc = (const bf16*)(F.ws + WS_VCPT) + (size_t)(b * 2 + g) * 64 * 128;
    const int hic = (qpos - 31) >> 4;
    Soft st; soft_init(st, 0.f);
    auto en_all = [](int) { return true; };
    auto mode_full = [](int) { return 2; };
    const int nct = (q0 + 63 >= 31 + 16 * 64) ? 2 : 1;
    attn_branch_lds(st, qf, kv, Kc, 64, Vc, 128, 0, nct - 1, 3u, 0, hic, en_all, mode_full, tid, r32, h);
    const float lc = st.l + __shfl_xor(st.l, 32), mc = st.m, rlc = 1.0f / fmaxf(lc, 1e-30f);
    soft_finish(a0, a1, st, gc);
    if (qb <= 15) { if (tid < 64) sel[tid] = (2u << qb) - 1u; if (tid == 64) anysel[0] = (2u << qb) - 1u; }
    else {
    for (int t = 0; t < 2; ++t) {
        f32x16 p[2]; const bool have = t < nct;
        if (have) {
#pragma unroll
            for (int kh = 0; kh < 2; ++kh) { p[kh] = (f32x16)(0.f);
#pragma unroll
                for (int s = 0; s < 4; ++s) { const bf16x8 kf = *(const LAS bf16x8*)(kv + t * KV_STAGE + (32 * kh + r32) * KT_PITCH + s * 32 + h * 16); p[kh] = mfma32(kf, qf[s], p[kh]); } }
        }
        for (int turn = 0; turn < 4; ++turn) {
            if (turn == hh) {
#pragma unroll
                for (int kh = 0; kh < 2; ++kh)
#pragma unroll
                    for (int i = 0; i < 16; ++i) { const int bi = 64 * t + 32 * kh + crow(i, h);
                        const float pn = (have && bi <= hic) ? fexp2(p[kh][i] - mc) * rlc : 0.f;
                        LAS float* d = psT + bi * 64 + ql; if (turn == 0) *d = pn; else *d += pn; }
            }
            __syncthreads();
        }
    }
    for (int it = 0; it < 4; ++it) { const int q = tid & 63, j = (tid >> 6) + 8 * it; float s = 0.f;
#pragma unroll
        for (int i = 4 * j - 1; i <= 4 * j + 3; ++i) if (i >= 0 && i <= 126) s += psT[i * 64 + q];
        float v = (j == 0 || j == qb || j == qb - 1) ? 1e4f : s; if (j > qb) v = -1.0f;
        sc[j * 64 + q] = v; }
    __syncthreads();
    for (int it = 0; it < 4; ++it) { const int q = tid & 63, j = (tid >> 6) + 8 * it; const float v = sc[j * 64 + q]; int rank = 0;
#pragma unroll
        for (int j2 = 0; j2 < 32; ++j2) { const float w = sc[j2 * 64 + q]; rank += (w > v || (w == v && j2 < j)) ? 1 : 0; }
        if (rank < 16 && j <= qb) { atomicOr((unsigned*)&sel[q], 1u << j); atomicOr((unsigned*)anysel, 1u << j); } }
    }
    __syncthreads();
    const unsigned mysel = sel[ql], tmask = anysel[0];
    soft_init(st, 0.f);
    { const bf16* Ks = (const bf16*)(F.ws + WS_KS) + (size_t)b * SEQ * 128 + g * 64;
      const bf16* Vs = (const bf16*)(F.ws + WS_VST) + (size_t)(b * 2 + g) * 64 * SEQ;
      auto en_sel = [mysel](int j) { return ((mysel >> j) & 1u) != 0u; };
      auto mode_sel = [qb](int j) { return (j == qb) ? 2 : (qb <= 15 ? 0 : 1); };
      attn_branch_lds(st, qf, kv, Ks, 128, Vs, SEQ, 0, qb, tmask, -1, qpos, en_sel, mode_sel, tid, r32, h); }
    soft_finish(a0, a1, st, gs);
    soft_init(st, 0.f);
    { const bf16* Kw = (const bf16*)(F.ws + WS_KW) + (size_t)b * SEQ * 128 + g * 64;
      const bf16* Vw = (const bf16*)(F.ws + WS_VWT) + (size_t)(b * 2 + g) * 64 * SEQ;
      auto mode_win = [qb](int j) { return (j == qb || j == qb - 8) ? 2 : 0; };
      attn_branch_lds(st, qf, kv, Kw, 128, Vw, SEQ, (qb >= 8) ? qb - 8 : 0, qb, 0xffffffffu, qpos - 512, qpos, en_all, mode_win, tid, r32, h); }
    soft_finish(a0, a1, st, gw_);
    const bf16* ga = (const bf16*)(F.ws + WS_GA) + mrow * 512 + (g * 4 + hh) * 64;
    bf16* oa = (bf16*)(F.ws + WS_OA) + mrow * 512 + (g * 4 + hh) * 64;
#pragma unroll
    for (int dh = 0; dh < 2; ++dh)
#pragma unroll
        for (int a = 0; a < 4; ++a) { const int d = 32 * dh + 8 * a + 4 * h; const u32x2 gv = *(const u32x2*)(ga + d);
            const f32x16& o = dh ? a1 : a0;
            const float x0 = o[4 * a] * __uint_as_float(gv.x << 16), x1 = o[4 * a + 1] * __uint_as_float(gv.x & 0xffff0000u), x2 = o[4 * a + 2] * __uint_as_float(gv.y << 16), x3 = o[4 * a + 3] * __uint_as_float(gv.y & 0xffff0000u);
            *(u32x2*)(oa + d) = (u32x2){pk2(x0, x1), pk2(x2, x3)}; }
    __syncthreads();
}

__device__ __forceinline__ void attn_half_f32(Soft& st, const bf16x8 (&qf)[4], const float* kb, const float* vb, int nrows, int kpos0, int lo, int hi, bool en,
                                              LAS float* sdump, int kidx0, int r32, int h) {
    f32x16 p = (f32x16)(0.f);
    { const int kr = (r32 < nrows) ? r32 : nrows - 1; const float* kp = kb + (size_t)kr * 128 + 8 * h;
      f32x4 kq[8];
#pragma unroll
      for (int s = 0; s < 4; ++s) { kq[2 * s] = *(const f32x4*)(kp + 16 * s); kq[2 * s + 1] = *(const f32x4*)(kp + 16 * s + 4); }
#pragma unroll
      for (int s = 0; s < 4; ++s) p = mfma32(pack8v(kq[2 * s], kq[2 * s + 1]), qf[s], p); }
    float vv[2][2][8];
#pragma unroll
    for (int dh = 0; dh < 2; ++dh)
#pragma unroll
        for (int s = 0; s < 2; ++s)
#pragma unroll
            for (int e = 0; e < 8; ++e) { int kr = 16 * s + 8 * (e >> 2) + 4 * h + (e & 3); kr = (kr < nrows) ? kr : nrows - 1; vv[dh][s][e] = __builtin_nontemporal_load(vb + (size_t)kr * 128 + 32 * dh + r32); }
    float mx = -INFINITY;
#pragma unroll
    for (int i = 0; i < 16; ++i) { const int kp = kpos0 + crow(i, h); const bool ok = en && kp >= lo && kp <= hi; p[i] = ok ? p[i] : -INFINITY; mx = fmaxf(mx, p[i]); }
    if (kidx0 >= 0 && r32 < 16) {
#pragma unroll
        for (int i = 0; i < 16; ++i) sdump[(kidx0 + crow(i, h)) * 16 + r32] = p[i];
    }
    mx = fmaxf(mx, __shfl_xor(mx, 32));
    const float mn = fmaxf(st.m, mx), alpha = fexp2(st.m - mn); st.m = mn;
    float sum = 0.f;
#pragma unroll
    for (int i = 0; i < 16; ++i) { p[i] = fexp2(p[i] - mn); sum += p[i]; }
    st.l = st.l * alpha + sum; st.o0 *= alpha; st.o1 *= alpha;
#pragma unroll
    for (int s = 0; s < 2; ++s) {
        const bf16x8 pb = pack8(p[8 * s], p[8 * s + 1], p[8 * s + 2], p[8 * s + 3], p[8 * s + 4], p[8 * s + 5], p[8 * s + 6], p[8 * s + 7]);
        st.o0 = mfma32(pack8(vv[0][s][0], vv[0][s][1], vv[0][s][2], vv[0][s][3], vv[0][s][4], vv[0][s][5], vv[0][s][6], vv[0][s][7]), pb, st.o0);
        st.o1 = mfma32(pack8(vv[1][s][0], vv[1][s][1], vv[1][s][2], vv[1][s][3], vv[1][s][4], vv[1][s][5], vv[1][s][6], vv[1][s][7]), pb, st.o1);
    }
}
constexpr int SA_SS = 0;
constexpr int SA_WP = 65536;
constexpr int SA_WP_STRIDE = (64 * 16 + 32) * 4;
constexpr int SA_OUT = SA_WP + 8 * SA_WP_STRIDE;
constexpr int SA_ML = SA_OUT + 4096;
constexpr int SA_SCS = SA_ML + 128;
constexpr int SA_SEL = SA_SCS + 4 * 260 * 4;
constexpr int SA_LIST = SA_SEL + 4 * 260;
constexpr int SA_GT = SA_LIST + 296;
constexpr int SA_END = SA_GT + 192;
static_assert(SA_END <= RING_BYTES, "sample attention LDS map");
__device__ __forceinline__ void sample_combine(Frame& F, Soft& st, int br, bool first, bool want_ml, int r32, int h) {
    LAS unsigned char* lds = F.lds; const int wave = F.wave, tid = F.tid;
    LAS float* wp = (LAS float*)(lds + SA_WP + wave * SA_WP_STRIDE);
    const float ltot = st.l + __shfl_xor(st.l, 32);
    if (r32 < 16) {
#pragma unroll
        for (int i = 0; i < 16; ++i) { wp[crow(i, h) * 16 + r32] = st.o0[i]; wp[(32 + crow(i, h)) * 16 + r32] = st.o1[i]; }
        if (h == 0) { wp[1024 + r32] = st.m; wp[1040 + r32] = ltot; }
    }
    __syncthreads();
    LAS float* OUT = (LAS float*)(lds + SA_OUT); LAS float* ML = (LAS float*)(lds + SA_ML); const LAS float* GT = (const LAS float*)(lds + SA_GT);
    for (int e = tid; e < 1024; e += NTHR) { const int col = e & 15, d = e >> 4;
        float mm = -1e30f;
#pragma unroll
        for (int w = 0; w < 8; ++w) mm = fmaxf(mm, ((const LAS float*)(lds + SA_WP + w * SA_WP_STRIDE))[1024 + col]);
        float L = 0.f, O = 0.f;
#pragma unroll
        for (int w = 0; w < 8; ++w) { const LAS float* q = (const LAS float*)(lds + SA_WP + w * SA_WP_STRIDE); const float f = fexp2(q[1024 + col] - mm); L += q[1040 + col] * f; O += q[d * 16 + col] * f; }
        const float v = GT[col * 3 + br] * O / fmaxf(L, 1e-30f);
        if (first) OUT[col * 64 + d] = v; else OUT[col * 64 + d] += v;
        if (want_ml && d == 0) { ML[col * 2] = mm; ML[col * 2 + 1] = 1.0f / fmaxf(L, 1e-30f); }
    }
    __syncthreads();
}
__device__ __forceinline__ void attn_sample_unit(Frame& F, int b, int g) {
    const int tid = F.tid, lane = F.lane, wave = F.wave, r32 = lane & 31, h = lane >> 5;
    const int col = r32 & 15, qi = col >> 2, hh = col & 3, qpos = PAST + qi;
    const size_t mrow = (size_t)MP + b * 4 + qi;
    LAS unsigned char* lds = F.lds;
    LAS float* SS = (LAS float*)(lds + SA_SS); LAS float* ML = (LAS float*)(lds + SA_ML); LAS float* SCS = (LAS float*)(lds + SA_SCS);
    LAS unsigned char* SEL = lds + SA_SEL; LAS int* LIST = (LAS int*)(lds + SA_LIST); LAS float* GT = (LAS float*)(lds + SA_GT);
    bf16x8 qf[4];
    { const bf16* qp = (const bf16*)(F.ws + WS_QB) + mrow * 512 + (g * 4 + hh) * 64 + 8 * h;
#pragma unroll
      for (int s = 0; s < 4; ++s) qf[s] = *(const bf16x8*)(qp + 16 * s); }
    __syncthreads();
    if (tid < 48) { const int c = tid / 3, br = tid % 3; GT[tid] = ((const float*)(F.ws + WS_GN))[((size_t)MP + b * 4 + (c >> 2)) * 32 + g * 12 + (c & 3) * 3 + br];
    }
    __syncthreads();
    const int* pt = (const int*)F.in[I_PT] + b * 128;
    Soft st;
    soft_init(st);
    { const float* kc = (const float*)(F.ws + WS_KCS) + (size_t)b * 1024 * 128 + g * 64; const float* vc = (const float*)(F.ws + WS_VCS) + (size_t)b * 1024 * 128 + g * 64;
      for (int ht = wave; ht < 32; ht += 8)
          attn_half_f32(st, qf, kc + (size_t)ht * 32 * 128, vc + (size_t)ht * 32 * 128, 32, 32 * ht, 0, 1022, true, SS, 32 * ht, r32, h); }
    sample_combine(F, st, 0, true, true, r32, h);
    if (tid < 4) { SCS[tid * 260 + 256] = 1e4f; SEL[tid * 260 + 256] = 1; }
    for (int e = tid; e < 4 * 256; e += NTHR) { const int q = e >> 8, j = e & 255; float s = 0.f;
        for (int i = 4 * j - 1; i <= 4 * j + 3; ++i) if (i >= 0 && i <= 1022) {
#pragma unroll
            for (int x = 0; x < 4; ++x) { const int c = q * 4 + x; s += fexp2(SS[i * 16 + c] - ML[c * 2]) * ML[c * 2 + 1]; } }
        SCS[q * 260 + j] = (j == 0 || j >= 255) ? 1e4f : s; }
    __syncthreads();
    for (int e = tid; e < 4 * 256; e += NTHR) { const int q = e >> 8, j = e & 255; const float v = SCS[q * 260 + j]; int rank = 0;
        for (int j2 = 0; j2 < 257; ++j2) { const float w = SCS[q * 260 + j2]; rank += (w > v || (w == v && j2 < j)) ? 1 : 0; }
        SEL[q * 260 + j] = (rank < 16) ? 1 : 0; }
    __syncthreads();
    if (wave == 0) { int cnt = 0;
        for (int base = 0; base < 257; base += 64) { const int j = base + lane;
            const bool f = (j < 257) && ((SEL[j] | SEL[260 + j] | SEL[520 + j] | SEL[780 + j]) != 0);
            const unsigned long long mk = __ballot(f);
            if (f) LIST[1 + cnt + __popcll(mk & ((1ull << lane) - 1ull))] = j;
            cnt += __popcll(mk); }
        if (lane == 0) LIST[0] = cnt; }
    __syncthreads();
    const int nsel = LIST[0];
    soft_init(st);
    for (int idx = wave; idx < 2 * nsel; idx += 8) { const int j = LIST[1 + (idx >> 1)], kh = idx & 1; const bool en = SEL[qi * 260 + j] != 0;
        if (j < 256) { const size_t ro = ((size_t)pt[j >> 1] * 128 + (j & 1) * 64 + 32 * kh) * 128 + g * 64;
            attn_half_f32(st, qf, IN_F(I_CKS) + ro, IN_F(I_CVS) + ro, 32, 64 * j + 32 * kh, 0, qpos, en, SS, -1, r32, h); }
        else if (kh == 0) { const size_t ro = (size_t)(b * 4) * 128 + g * 64;
            attn_half_f32(st, qf, F.out + O_SKS + ro, F.out + O_SVS + ro, 4, PAST, 0, qpos, en, SS, -1, r32, h); } }
    sample_combine(F, st, 1, false, false, r32, h);
    soft_init(st);
    for (int idx = wave; idx < 17; idx += 8) {
        if (idx < 16) { const size_t ro = ((size_t)b * 512 + 32 * idx) * 128 + g * 64;
            attn_half_f32(st, qf, IN_F(I_CKW) + ro, IN_F(I_CVW) + ro, 32, PAST - 512 + 32 * idx, qpos - 512, qpos, true, SS, -1, r32, h); }
        else { const size_t ro = ((size_t)b * 512 + 508) * 128 + g * 64;
            attn_half_f32(st, qf, F.out + O_SKW + ro, F.out + O_SVW + ro, 4, PAST, qpos - 512, qpos, true, SS, -1, r32, h); } }
    sample_combine(F, st, 2, false, false, r32, h);
    { const LAS float* OUT = (const LAS float*)(lds + SA_OUT);
      for (int e = tid; e < 1024; e += NTHR) { const int c = e >> 6, d = e & 63; const size_t m = (size_t)MP + b * 4 + (c >> 2); const int cc = (g * 4 + (c & 3)) * 64 + d;
          ((bf16*)(F.ws + WS_OA))[m * 512 + cc] = (bf16)(pk2(OUT[c * 64 + d] * bf2f(((const bf16*)(F.ws + WS_GA))[m * 512 + cc]), 0.f) & 0xffffu);
      } }
    __syncthreads();
}

__device__ __forceinline__ void unpack8(const u32x4 w, float (&f)[8]) {
    f[0] = __uint_as_float(w.x << 16); f[1] = __uint_as_float(w.x & 0xffff0000u); f[2] = __uint_as_float(w.y << 16); f[3] = __uint_as_float(w.y & 0xffff0000u);
    f[4] = __uint_as_float(w.z << 16); f[5] = __uint_as_float(w.z & 0xffff0000u); f[6] = __uint_as_float(w.w << 16); f[7] = __uint_as_float(w.w & 0xffff0000u);
}
template <int MODE> struct EpiMul {
    static constexpr bool PERM = true, AFTER_DRAIN = false;
    unsigned char* ws; const float* bias;
    __device__ __forceinline__ void operator()(const pg8::f32x4 (&acc)[2][2][4][2], const pg8::Unit& u, int wr, int wc, int fr, int fq) const {
#pragma unroll
        for (int ai = 0; ai < 2; ++ai)
#pragma unroll
            for (int m = 0; m < 4; ++m) { const size_t r = (size_t)u.pm * 256 + ai * 128 + wr * 64 + m * 16 + fr;
#pragma unroll
                for (int bj = 0; bj < 2; ++bj) { const int c = u.pn * 256 + bj * 128 + wc * 32 + 8 * fq;
                    float v[8]; const pg8::f32x4 v0 = acc[ai][bj][m][0], v1 = acc[ai][bj][m][1];
                    v[0] = v0.x; v[1] = v0.y; v[2] = v0.z; v[3] = v0.w; v[4] = v1.x; v[5] = v1.y; v[6] = v1.z; v[7] = v1.w;
                    float gt[8];
                    if (MODE == 0) { unpack8(*(const u32x4*)((const bf16*)(ws + WS_GB) + r * 512 + c), gt); const f32x4 b0 = *(const f32x4*)(bias + c), b1 = *(const f32x4*)(bias + c + 4);
                        v[0] += b0.x; v[1] += b0.y; v[2] += b0.z; v[3] += b0.w; v[4] += b1.x; v[5] += b1.y; v[6] += b1.z; v[7] += b1.w; }
                    else unpack8(*(const u32x4*)((const bf16*)(ws + WS_MG) + r * 2048 + (MODE == 2 ? 1024 : 0) + c), gt);
#pragma unroll
                    for (int e = 0; e < 8; ++e) v[e] *= gt[e];
                    bf16* dst = (MODE == 0) ? (bf16*)(ws + WS_CB) + r * 512 + c : (MODE == 1) ? (bf16*)(ws + WS_T1) + r * 1024 + c : (bf16*)(ws + WS_H) + r * 1024 + c;
                    if (MODE == 2) { float t[8]; unpack8(*(const u32x4*)((const bf16*)(ws + WS_T1) + r * 1024 + c), t);
#pragma unroll
                        for (int e = 0; e < 8; ++e) v[e] += t[e]; }
                    *(u32x4*)dst = (u32x4){pk2(v[0], v[1]), pk2(v[2], v[3]), pk2(v[4], v[5]), pk2(v[6], v[7])}; } }
    }
};
struct PairOrder {
    pg8::StaticOrder S;
    __device__ __forceinline__ bool next(int i, pg8::Unit& u) const { pg8::Unit b; if (!S.next(i >> 1, b)) return false;
        if (i & 1) { u.pm = b.pm; u.pn = b.pn + 4; } else { u.pm = b.pm + 68; u.pn = b.pn; } return true; }
    __device__ __forceinline__ void a_ready(const pg8::Unit&) const {}
    __device__ __forceinline__ void done(const pg8::Unit&) const {}
};
struct EpiMulAB {
    static constexpr bool PERM = true, AFTER_DRAIN = false;
    unsigned char* ws;
    __device__ __forceinline__ void operator()(const pg8::f32x4 (&acc)[2][2][4][2], const pg8::Unit& u, int wr, int wc, int fr, int fq) const {
        if (u.pn >= 4) { asm volatile("s_waitcnt vmcnt(0)" ::: "memory");
            const pg8::Unit v{u.pm, u.pn - 4}; EpiMul<2>{ws, nullptr}(acc, v, wr, wc, fr, fq); }
        else { const pg8::Unit v{u.pm - 68, u.pn}; EpiMul<1>{ws, nullptr}(acc, v, wr, wc, fr, fq); }
    }
};
struct EpiOut {
    static constexpr bool PERM = true, AFTER_DRAIN = false;
    unsigned char* ws; float* out; const float* xp; const float* xs;
    __device__ __forceinline__ void operator()(const pg8::f32x4 (&acc)[2][2][4][2], const pg8::Unit& u, int wr, int wc, int fr, int fq) const {
#pragma unroll
        for (int ai = 0; ai < 2; ++ai)
#pragma unroll
            for (int m = 0; m < 4; ++m) { const int r = u.pm * 256 + ai * 128 + wr * 64 + m * 16 + fr; const bool ok = r < MR;
                const float* xr = (r < MP) ? xp + (size_t)r * D : xs + (size_t)(ok ? r - MP : 0) * D;
                float ss = 0.f;
#pragma unroll
                for (int bj = 0; bj < 2; ++bj) { const int c = u.pn * 256 + bj * 128 + wc * 32 + 8 * fq;
                    f32x4 o0 = acc[ai][bj][m][0], o1 = acc[ai][bj][m][1];
                    if (ok) { o0 += *(const f32x4*)(xr + c); o1 += *(const f32x4*)(xr + c + 4);
                        *(u32x4*)((bf16*)(ws + WS_T1) + (size_t)r * D + c) = (u32x4){pk2(o0.x, o0.y), pk2(o0.z, o0.w), pk2(o1.x, o1.y), pk2(o1.z, o1.w)}; }
                    ss += (o0.x * o0.x + o0.y * o0.y) + (o0.z * o0.z + o0.w * o0.w) + (o1.x * o1.x + o1.y * o1.y) + (o1.z * o1.z + o1.w * o1.w); }
                ss += __shfl_xor(ss, 16); ss += __shfl_xor(ss, 32);
                if (fq == 0) ((float*)(ws + WS_RSS))[(size_t)r * 16 + u.pn * 4 + wc] = ss; }
    }
};

constexpr size_t WS_RSSS = WS_RSS + 1100 * 1024;
__device__ __forceinline__ f32x16 wave_tile_partial(const bf16* A, int lda, const bf16* Bt, int ldb, int k0, int ksteps, int r32, int h) {
    f32x16 acc = (f32x16)(0.f);
    const bf16* ap = A + (size_t)r32 * lda + k0 + 8 * h; const bf16* bp = Bt + (size_t)r32 * ldb + k0 + 8 * h;
#pragma unroll 8
    for (int s = 0; s < ksteps; ++s) { const bf16x8 a = *(const bf16x8*)(ap + 16 * s), b = *(const bf16x8*)(bp + 16 * s); acc = mfma32(a, b, acc); }
    return acc;
}
__device__ __forceinline__ void sample_rows_p4(Frame& F) {
    if (F.vcu >= 128) return;
    const int lane = F.lane, wave = F.wave, r32 = lane & 31, h = lane >> 5, tid = F.tid;
    const int rg = F.vcu >> 5, cg = F.vcu & 31, row0 = MP + 32 * rg, col0 = 32 * cg;
    LAS float* P = (LAS float*)F.lds;
    float ga[2], gb[2];
#pragma unroll
    for (int q = 0; q < 2; ++q) { const int e = tid + q * NTHR; const int i = e >> 6, ln = e & 63; const size_t row = row0 + crow(i, ln >> 5); const int col = col0 + (ln & 31);
        const bf16* mg = (const bf16*)(F.ws + WS_MG) + row * 2048 + col; ga[q] = bf2f(mg[0]); gb[q] = bf2f(mg[1024]); }
    const f32x16 a1 = wave_tile_partial((const bf16*)(F.ws + WS_OA) + (size_t)row0 * 512, 512, (const bf16*)(F.ws + WS_WPA_T) + (size_t)col0 * 512, 512, 64 * wave, 4, r32, h);
    const f32x16 a2 = wave_tile_partial((const bf16*)(F.ws + WS_CB) + (size_t)row0 * 512, 512, (const bf16*)(F.ws + WS_WPB_T) + (size_t)col0 * 512, 512, 64 * wave, 4, r32, h);
    __syncthreads();
#pragma unroll
    for (int i = 0; i < 16; ++i) { P[(wave * 2) * 1024 + i * 64 + lane] = a1[i]; P[(wave * 2 + 1) * 1024 + i * 64 + lane] = a2[i]; }
    __syncthreads();
#pragma unroll
    for (int q = 0; q < 2; ++q) { const int e = tid + q * NTHR; float s1 = 0.f, s2 = 0.f;
#pragma unroll
        for (int w = 0; w < 8; ++w) { s1 += P[(w * 2) * 1024 + e]; s2 += P[(w * 2 + 1) * 1024 + e]; }
        const int i = e >> 6, ln = e & 63; const size_t row = row0 + crow(i, ln >> 5); const int col = col0 + (ln & 31);
        ((bf16*)(F.ws + WS_H))[row * 1024 + col] = (bf16)(pk2(ga[q] * s1 + gb[q] * s2, 0.f) & 0xffffu); }
    __syncthreads();
}
__device__ __forceinline__ void sample_rows_p5(Frame& F) {
    if (F.vcu >= 128) return;
    const int lane = F.lane, wave = F.wave, r32 = lane & 31, h = lane >> 5, tid = F.tid;
    const int rg = F.vcu >> 5, cg = F.vcu & 31, row0 = MP + 32 * rg, col0 = 32 * cg;
    LAS float* P = (LAS float*)F.lds;
    float xr[2];
#pragma unroll
    for (int q = 0; q < 2; ++q) { const int e = tid + q * NTHR; const int i = e >> 6, ln = e & 63; xr[q] = IN_F(I_XS)[(size_t)(32 * rg + crow(i, ln >> 5)) * D + col0 + (ln & 31)]; }
    const f32x16 a1 = wave_tile_partial((const bf16*)(F.ws + WS_H) + (size_t)row0 * 1024, 1024, (const bf16*)(F.ws + WS_WO_T) + (size_t)col0 * 1024, 1024, 128 * wave, 8, r32, h);
    __syncthreads();
#pragma unroll
    for (int i = 0; i < 16; ++i) P[wave * 1024 + i * 64 + lane] = a1[i];
    __syncthreads();
#pragma unroll
    for (int q = 0; q < 2; ++q) { const int e = tid + q * NTHR; float s1 = 0.f;
#pragma unroll
        for (int w = 0; w < 8; ++w) s1 += P[w * 1024 + e];
        const int i = e >> 6, ln = e & 63; const int srow = 32 * rg + crow(i, ln >> 5), col = col0 + (ln & 31);
        const float o = xr[q] + s1;
        ((bf16*)(F.ws + WS_T1))[(size_t)(MP + srow) * D + col] = (bf16)(pk2(o, 0.f) & 0xffffu);
        float ss = o * o;
        ss += __shfl_xor(ss, 1); ss += __shfl_xor(ss, 2); ss += __shfl_xor(ss, 4); ss += __shfl_xor(ss, 8); ss += __shfl_xor(ss, 16);
        if ((ln & 31) == 0) ((float*)(F.ws + WS_RSSS))[srow * 32 + cg] = ss; }
    __syncthreads();
}

constexpr int N_PHASES = 7;
struct Args { const void* in[28]; float* out; unsigned char* ws; int ph_lo, ph_hi; };
__global__ void __launch_bounds__(NTHR, 2) nsa_fwd(Args args) {
    extern __shared__ __attribute__((aligned(16))) unsigned char lds_raw[];
    Frame F;
    F.lds = (LAS unsigned char*)lds_raw;
    F.MISC = (volatile LAS unsigned*)(F.lds + MISC_OFF);
    F.tid = threadIdx.x; F.lane = F.tid & 63; F.wave = __builtin_amdgcn_readfirstlane(F.tid >> 6);
    F.G = gridDim.x; { const int bx = blockIdx.x; F.vcu = (F.G % 8 == 0) ? (bx % 8) * (F.G / 8) + bx / 8 : bx; }
#pragma unroll
    for (int i = 0; i < 28; ++i) F.in[i] = (const float*)args.in[i];
    F.out = args.out; F.ws = args.ws; F.ctl = (gu32*)(args.ws + WS_CTL);
    for (int u = F.tid; u < (LDS_BYTES - LDSCTL_OFF) / 4; u += NTHR) ((LAS unsigned*)(F.lds + LDSCTL_OFF))[u] = 0u;
    __syncthreads();
    const int lo = args.ph_lo, hi = args.ph_hi;
    const bool multi = (hi - lo) > 1;
    XcdBarrier bar; bar.bar = (unsigned*)(F.ctl + CW_BAR); bar.x = 0; bar.st = nullptr;
    if (multi) bar = xcd_barrier_post((unsigned*)(F.ctl + CW_BAR), F.MISC + 8);
#define IN(k) (lo <= (k) && (k) < hi)
#define BOTH(k) (IN(k) && ((k) + 1) < hi)
#define GRID_BAR() xcd_barrier(bar)

    if (IN(0)) { p0_prologue(F, 0, F.vcu, F.G); if (BOTH(0)) GRID_BAR(); }

    if (IN(1)) {
        pg8::Gemm g{(const pg8::bf16_t*)(F.ws + WS_XN), (const pg8::bf16_t*)(F.ws + WS_WIN_T), M, NPADW, D}; pg8::StaticOrder S; S.init(M, NPADW, F.G, (int)blockIdx.x);
        EpiIn E{F.ws, F.out};
        pg8::gemm_phase<EpiIn, pg8::StaticOrder, true, true>(F.lds, g, S, E);
        { const int nlast = S.nwg % F.G;
          if (nlast == 0) p0_prologue(F, 1, F.vcu, F.G); else if ((int)blockIdx.x >= nlast) { __syncthreads(); p0_prologue(F, 1, (int)blockIdx.x - nlast, F.G - nlast); } }
        if (BOTH(1)) GRID_BAR();
    }

    if (IN(2)) {
        const int cls = F.vcu % 3;
        auto conv_all = [&]() __attribute__((always_inline)) {
            float kw[31];
#pragma unroll
            for (int w = 0; w < 31; ++w) kw[w] = IN_F(I_DWK)[w * 512 + F.tid];
            const float cbias = IN_F(I_DWB)[F.tid], clg = IN_F(I_CLNG)[F.tid], clb = IN_F(I_CLNB)[F.tid];
            u32x4 cvv[8];
            int u = F.G - 1 - F.vcu;
            if (u < 512 + DB) conv_load(F, u, cvv);
            while (u < 512 + DB) { const int un = u + F.G; const bool pre = un < 512;
                conv_unit(F, u, pre ? un : -1, cvv, kw, cbias, clg, clb);
                if (!pre && un < 512 + DB) conv_load(F, un, cvv);
                u = un; }
            __syncthreads();
        };
        if (cls == 0) conv_all();
        compress_jobs(F, F.vcu, F.vcu + 1);
        if (cls == 1) conv_all();
        compress_jobs(F, F.vcu + F.G, 0x7fffffff);
        if (cls == 2) conv_all();
        compress_tail(F);
        if (BOTH(2)) GRID_BAR();
    }

    if (IN(3)) {
        constexpr int NSAMP = 2 * DB;
        const bool samp_cu = (F.G >= 4 * NSAMP) ? ((F.vcu & 3) == 0 && (F.vcu >> 2) < NSAMP) : (F.vcu < NSAMP);
        const int samp_id = (F.G >= 4 * NSAMP) ? (F.vcu >> 2) : F.vcu;
        const int gemm_id = (F.G >= 4 * NSAMP) ? ((F.vcu >> 2) < NSAMP ? F.vcu - (F.vcu >> 2) - 1 : F.vcu - NSAMP) : F.vcu - NSAMP;
        if (samp_cu) { attn_sample_unit(F, samp_id >> 1, samp_id & 1); }
        else {
            pg8::Gemm g{(const pg8::bf16_t*)(F.ws + WS_APW), (const pg8::bf16_t*)(F.ws + WS_PW_T), M, 512, 512}; pg8::StaticOrder S; S.init(M, 512, F.G - NSAMP, gemm_id);
            EpiMul<0> E{F.ws, IN_F(I_PWB)};
            pg8::gemm_phase<EpiMul<0>, pg8::StaticOrder, true, true>(F.lds, g, S, E);
        }
        int item;
        for (;;) {
            __syncthreads();
            if (F.tid == 0) F.MISC[0] = __hip_atomic_fetch_add((unsigned*)(F.ctl + CW_QATT), 1u, __ATOMIC_RELAXED, __HIP_MEMORY_SCOPE_AGENT);
            __syncthreads();
            item = (int)F.MISC[0];
            if (item >= 512) break;
            attn_prompt_unit(F, (item & 15) >> 1, item & 1, 31 - (item >> 4));
        }
        while (item < 512 + 2 * F.G) {
            p0_prologue(F, 2, item - 512, 2 * F.G);
            __syncthreads();
            if (F.tid == 0) F.MISC[0] = __hip_atomic_fetch_add((unsigned*)(F.ctl + CW_QATT), 1u, __ATOMIC_RELAXED, __HIP_MEMORY_SCOPE_AGENT);
            __syncthreads();
            item = (int)F.MISC[0];
        }
        if (BOTH(3)) GRID_BAR();
    }

    if (IN(4)) {
        sample_rows_p4(F);
        static_assert(WS_OA - WS_CB == (size_t)68 * 256 * 512 * 2 && WS_WPB_T - WS_WPA_T == (size_t)4 * 256 * 512 * 2, "stacked operand layout");
        PairOrder S; S.S.init(MP, D, F.G, (int)blockIdx.x);
        pg8::Gemm g{(const pg8::bf16_t*)(F.ws + WS_CB), (const pg8::bf16_t*)(F.ws + WS_WPA_T), MP, D, 512}; EpiMulAB E{F.ws};
        pg8::gemm_phase<EpiMulAB, PairOrder, true, true>(F.lds, g, S, E);
        if (BOTH(4)) GRID_BAR();
    }

    if (IN(5)) {
        sample_rows_p5(F);
        pg8::Gemm g{(const pg8::bf16_t*)(F.ws + WS_H), (const pg8::bf16_t*)(F.ws + WS_WO_T), MP, D, D}; pg8::StaticOrder S; S.init(MP, D, F.G, (int)blockIdx.x);
        EpiOut E{F.ws, F.out, IN_F(I_XP), IN_F(I_XS)};
        pg8::gemm_phase<EpiOut, pg8::StaticOrder, true, true>(F.lds, g, S, E);
        if (BOTH(5)) GRID_BAR();
    }

    if (IN(6)) {
        const int gw = F.vcu * NWAVES + F.wave, NGW = F.G * NWAVES, lane = F.lane;
        const float* fg = IN_F(I_FING);
        f32x4 gv[4];
#pragma unroll
        for (int j = 0; j < 4; ++j) gv[j] = *(const f32x4*)(fg + (lane + 64 * j) * 4);
        bool bar_dead = multi && (__hip_atomic_load((unsigned*)(F.ctl + CW_BAR) + XB_TMO, __ATOMIC_RELAXED, __HIP_MEMORY_SCOPE_AGENT) != 0u);
        for (int m0 = gw; m0 < MR; m0 += 4 * NGW) {
            f32x4 v[4][4]; float s[4];
#pragma unroll
            for (int q = 0; q < 4; ++q) { const int m = (m0 + q * NGW < MR) ? m0 + q * NGW : m0; const bf16* yr = (const bf16*)(F.ws + WS_T1) + (size_t)m * D;
                s[q] = (m < MP) ? ((lane < 16) ? ((const float*)(F.ws + WS_RSS))[(size_t)m * 16 + lane] : 0.f) : ((lane < 32) ? ((const float*)(F.ws + WS_RSSS))[(size_t)(m - MP) * 32 + lane] : 0.f);
#pragma unroll
                for (int j = 0; j < 4; ++j) { const u32x2 w = __builtin_nontemporal_load((const u32x2*)(yr + (lane + 64 * j) * 4)); v[q][j] = (f32x4){__uint_as_float(w.x << 16), __uint_as_float(w.x & 0xffff0000u), __uint_as_float(w.y << 16), __uint_as_float(w.y & 0xffff0000u)}; } }
#pragma unroll
            for (int q = 0; q < 4; ++q) { const int m = m0 + q * NGW; if (m >= MR) continue;
                float* yr = F.out + O_Y + (size_t)m * D;
                float rstd = 1.0f / sqrtf(wave_sum(s[q]) * (1.f / D) + EPS);
                if (bar_dead) rstd = __builtin_nanf("");
#pragma unroll
                for (int j = 0; j < 4; ++j) __builtin_nontemporal_store(v[q][j] * rstd * gv[j], (f32x4*)(yr + (lane + 64 * j) * 4)); }
        }
    }
#undef IN
#undef BOTH
#undef GRID_BAR
}

#ifndef MK_N_LAUNCHES
#define MK_N_LAUNCHES 7
#endif
extern "C" void kernel_launch(void* const* d_in, const int* in_sizes, int n_in, void* d_out, int out_size, void* d_ws, size_t ws_size, hipStream_t stream) {
    static int grid = 0;
    if (grid == 0) {
        if (n_in != 28 || (size_t)out_size != O_END || ws_size < WS_END) { fprintf(stderr, "kernel_launch: unexpected sizes n_in %d out %d (want %zu) ws %zu (want >= %zu)\n", n_in, out_size, (size_t)O_END, ws_size, (size_t)WS_END); grid = -1; return; }
        int dev = 0, cus = 0, per_cu = 0;
        if (hipGetDevice(&dev) != hipSuccess || hipDeviceGetAttribute(&cus, hipDeviceAttributeMultiprocessorCount, dev) != hipSuccess) { grid = -1; return; }
        if (hipFuncSetAttribute((const void*)nsa_fwd, hipFuncAttributeMaxDynamicSharedMemorySize, LDS_BYTES) != hipSuccess) { fprintf(stderr, "kernel_launch: hipFuncSetAttribute failed\n"); grid = -1; return; }
        if (hipOccupancyMaxActiveBlocksPerMultiprocessor(&per_cu, (const void*)nsa_fwd, NTHR, LDS_BYTES) != hipSuccess || per_cu < 1)
            fprintf(stderr, "kernel_launch: note: occupancy query reports %d workgroups per CU\n", per_cu);
        (void)hipGetLastError();
        grid = cus;
        if (grid < 128) { fprintf(stderr, "kernel_launch: device has %d CUs; built for >= 128\n", grid); grid = -1; return; }
    }
    if (grid < 0) return;
    if (hipMemsetAsync((char*)d_ws + WS_CTL, 0, CTL_ZERO_BYTES, stream) != hipSuccess) return;
    Args a{};
    for (int i = 0; i < 28; ++i) a.in[i] = d_in[i];
    a.out = (float*)d_out; a.ws = (unsigned char*)d_ws;
    if (MK_N_LAUNCHES == 1) { a.ph_lo = 0; a.ph_hi = N_PHASES; hipLaunchKernelGGL(nsa_fwd, dim3(grid), dim3(NTHR), LDS_BYTES, stream, a); }
    else for (int p = 0; p < N_PHASES; ++p) {
        a.ph_lo = p; a.ph_hi = p + 1; hipLaunchKernelGGL(nsa_fwd, dim3(grid), dim3(NTHR), LDS_BYTES, stream, a); }
}
```
